# Optimizing an MI355X kernel written in HIP

```python
import jax, jax.numpy as jnp
from jax import lax
import numpy as np

D_MODEL = 1024
BATCH = 2
SEQ = 16384
DEPTH = 4

GRID_W = 64
CTX_LEN = 256
HEAD_DIM = 64
N_HEADS = 8
N_KV_HEADS = 2
Q_PER_KV = N_HEADS // N_KV_HEADS
ATTN_WIDTH = N_HEADS * HEAD_DIM
KV_WIDTH = N_KV_HEADS * HEAD_DIM
WINDOW = 128
BLOCK = 128
ROPE_BASE = 10000.0
SGU_GROUPS = 4
SGU_GROUP_DIM = 64
SGU_WIDTH = SGU_GROUPS * SGU_GROUP_DIM
CHUNK = 128
FNET_GROUPS = 4
FNET_GROUP_DIM = 64
FNET_WIDTH = FNET_GROUPS * FNET_GROUP_DIM
N_BRANCHES = 3
IN_SPLITS = [ATTN_WIDTH,
             ATTN_WIDTH + KV_WIDTH,
             ATTN_WIDTH + 2 * KV_WIDTH,
             ATTN_WIDTH + 2 * KV_WIDTH + SGU_WIDTH,
             ATTN_WIDTH + 2 * KV_WIDTH + 2 * SGU_WIDTH,
             ATTN_WIDTH + 2 * KV_WIDTH + 2 * SGU_WIDTH + FNET_WIDTH]
IN_WIDTH = IN_SPLITS[-1] + N_BRANCHES * D_MODEL
N_EXPERTS = 16
CAPACITY_FACTOR = 2
EXPERT_FF = 2048
N_MOD = 6
EPS = 1e-6
NEG_INF = -1e30

kernel_name = "hybrid_gated_branch_diffusion_block"


def rms_norm(x, g):
    xf = x.astype(jnp.float32)
    y = xf * lax.rsqrt(jnp.mean(xf * xf, axis=-1, keepdims=True) + EPS)
    return (y * g.astype(jnp.float32)).astype(x.dtype)


def modulate(h, shift, scale):
    return h * (1 + scale) + shift


def axial_rope(rows):
    row = jnp.repeat(jnp.arange(rows, dtype=jnp.float32), GRID_W)
    col = jnp.tile(jnp.arange(GRID_W, dtype=jnp.float32), rows)
    pairs = HEAD_DIM // 4
    inv = ROPE_BASE ** (-jnp.arange(pairs, dtype=jnp.float32) / pairs)
    ang = jnp.concatenate([row[:, None] * inv, col[:, None] * inv], axis=-1)
    return jnp.cos(ang)[:, None, :], jnp.sin(ang)[:, None, :]


def apply_rope(x, cos, sin):
    cos = cos.astype(x.dtype)
    sin = sin.astype(x.dtype)
    x1, x2 = jnp.split(x, 2, axis=-1)
    return jnp.concatenate([x1 * cos - x2 * sin, x2 * cos + x1 * sin], axis=-1)


def context_attention(q, k, v, sink):
    b, l, _, _ = q.shape
    qg = q.reshape(b, l, N_KV_HEADS, Q_PER_KV, HEAD_DIM).astype(jnp.float32) * (HEAD_DIM ** -0.5)
    s = jnp.einsum('blkgd,bmkd->bkglm', qg, k.astype(jnp.float32))
    sk = jnp.broadcast_to(sink.astype(jnp.float32).reshape(1, N_KV_HEADS, Q_PER_KV, 1, 1), s.shape[:-1] + (1,))
    p = jax.nn.softmax(jnp.concatenate([s, sk], axis=-1), axis=-1)
    o = jnp.einsum('bkglm,bmkd->blkgd', p[..., :l], v.astype(jnp.float32))
    return o.reshape(b, l, ATTN_WIDTH).astype(q.dtype)


def window_attention(q, k, v, k_ctx, v_ctx, sink):
    b, n, _, _ = q.shape
    l = k_ctx.shape[1]
    nb = n // BLOCK
    qb = q.reshape(b, nb, BLOCK, N_KV_HEADS, Q_PER_KV, HEAD_DIM).astype(jnp.float32) * (HEAD_DIM ** -0.5)

    def band(t):
        tp = jnp.pad(t, ((0, 0), (BLOCK, BLOCK), (0, 0), (0, 0))).reshape(b, nb + 2, BLOCK, N_KV_HEADS, HEAD_DIM)
        return jnp.concatenate([tp[:, :-2], tp[:, 1:-1], tp[:, 2:]], axis=2).astype(jnp.float32)

    kb = band(k)
    vb = band(v)
    s_loc = jnp.einsum('bnqkgd,bnskd->bnkgqs', qb, kb)
    qi = jnp.arange(BLOCK)[:, None]
    kj = jnp.arange(3 * BLOCK)[None, :]
    in_win = jnp.abs(kj - BLOCK - qi) <= WINDOW
    key_abs = (jnp.arange(nb)[:, None] - 1) * BLOCK + jnp.arange(3 * BLOCK)[None, :]
    in_range = (key_abs >= 0) & (key_abs < n)
    mask = in_win[None] & in_range[:, None, :]
    s_loc = jnp.where(mask[None, :, None, None], s_loc, NEG_INF)
    s_ctx = jnp.einsum('bnqkgd,bmkd->bnkgqm', qb, k_ctx.astype(jnp.float32))
    sk = jnp.broadcast_to(sink.astype(jnp.float32).reshape(1, 1, N_KV_HEADS, Q_PER_KV, 1, 1), s_ctx.shape[:-1] + (1,))
    p = jax.nn.softmax(jnp.concatenate([s_loc, s_ctx, sk], axis=-1), axis=-1)
    o = (jnp.einsum('bnkgqs,bnskd->bnqkgd', p[..., :3 * BLOCK], vb)
         + jnp.einsum('bnkgqm,bmkd->bnqkgd', p[..., 3 * BLOCK:3 * BLOCK + l], v_ctx.astype(jnp.float32)))
    return o.reshape(b, n, ATTN_WIDTH).astype(q.dtype)


def chunk_sgu(u, v, w_s, b_s):
    b, n, _ = u.shape
    u = jax.nn.gelu(u)
    vg = jax.nn.gelu(v).reshape(b, n // CHUNK, CHUNK, SGU_GROUPS, SGU_GROUP_DIM).astype(jnp.float32)
    vg = vg * lax.rsqrt(jnp.mean(vg * vg, axis=-1, keepdims=True) + EPS)
    z = jnp.einsum('gij,bcjgd->bcigd', w_s.astype(jnp.float32), vg) + b_s.astype(jnp.float32).T[None, None, :, :, None]
    return u * z.reshape(b, n, SGU_WIDTH).astype(u.dtype)


def fourier_mix(f):
    b, n, _ = f.shape
    fg = f.reshape(b, n, FNET_GROUPS, FNET_GROUP_DIM).astype(jnp.float32)
    y = jnp.fft.fft2(fg, axes=(1, 3), norm='ortho').real
    return y.reshape(b, n, FNET_WIDTH).astype(f.dtype)


def merge_branches(a, s, f, gates, w_ba, w_bs, w_bf, w_o):
    g_a, g_s, g_f = jnp.split(jax.nn.sigmoid(gates), N_BRANCHES, axis=-1)
    m = g_a * (a @ w_ba) + g_s * (s @ w_bs) + g_f * (f @ w_bf)
    return m @ w_o


def expert_choice(h, w_router, w_gate, w_up, w_down):
    b, n, d = h.shape
    cap = CAPACITY_FACTOR * n // N_EXPERTS
    aff = jax.nn.softmax((h @ w_router).astype(jnp.float32), axis=-1)
    gval, idx = lax.top_k(jnp.swapaxes(aff, 1, 2), cap)
    xe = jax.vmap(lambda hb, ib: hb[ib])(h, idx)
    a = jnp.einsum('becd,edf->becf', xe, w_gate)
    u = jnp.einsum('becd,edf->becf', xe, w_up)
    y = jnp.einsum('becf,efd->becd', jax.nn.silu(a) * u, w_down) * gval[..., None].astype(h.dtype)
    return jax.vmap(lambda yb, ib: jnp.zeros((n, d), h.dtype).at[ib.reshape(-1)].add(yb.reshape(-1, d)))(y, idx)


def setup_inputs(seed: int = 0) -> dict:
    key = jax.random.key(seed)
    ks = jax.random.split(key, 21)

    def nrm(k, shape, scale):
        return jax.random.normal(k, shape, jnp.float32) * scale

    D = D_MODEL
    return {
        "x": nrm(ks[0], (BATCH, SEQ, D), 1.0),
        "c": nrm(ks[1], (BATCH, D), 1.0),
        "ctx": nrm(ks[2], (BATCH, CTX_LEN, D), 1.0),
        "c_ctx": nrm(ks[3], (D,), 1.0),
        "w_mod": nrm(ks[4], (DEPTH, D, N_MOD * D), 0.5 * D ** -0.5),
        "b_mod": nrm(ks[5], (DEPTH, N_MOD * D), 0.02),
        "g_mix": 1.0 + nrm(ks[6], (DEPTH, D), 0.02),
        "g_ffn": 1.0 + nrm(ks[7], (DEPTH, D), 0.02),
        "w_in": nrm(ks[8], (DEPTH, D, IN_WIDTH), D ** -0.5),
        "attn_sink": nrm(ks[9], (DEPTH, N_HEADS), 0.5),
        "w_spatial": nrm(ks[10], (DEPTH, SGU_GROUPS, CHUNK, CHUNK), CHUNK ** -0.5),
        "b_spatial": nrm(ks[11], (DEPTH, SGU_GROUPS, CHUNK), 0.02),
        "w_branch_attn": nrm(ks[12], (DEPTH, ATTN_WIDTH, D), ATTN_WIDTH ** -0.5),
        "w_branch_sgu": nrm(ks[13], (DEPTH, SGU_WIDTH, D), SGU_WIDTH ** -0.5),
        "w_branch_fourier": nrm(ks[14], (DEPTH, FNET_WIDTH, D), FNET_WIDTH ** -0.5),
        "w_out": nrm(ks[15], (DEPTH, D, D), D ** -0.5),
        "w_router": nrm(ks[16], (DEPTH, D, N_EXPERTS), D ** -0.5),
        "w_gate": nrm(ks[17], (DEPTH, N_EXPERTS, D, EXPERT_FF), D ** -0.5),
        "w_up": nrm(ks[18], (DEPTH, N_EXPERTS, D, EXPERT_FF), D ** -0.5),
        "w_down": nrm(ks[19], (DEPTH, N_EXPERTS, EXPERT_FF, D), EXPERT_FF ** -0.5),
        "g_final": 1.0 + nrm(ks[20], (D,), 0.02),
    }


def reference(x, c, ctx, c_ctx, w_mod, b_mod, g_mix, g_ffn, w_in, attn_sink, w_spatial, b_spatial,
              w_branch_attn, w_branch_sgu, w_branch_fourier, w_out, w_router, w_gate, w_up, w_down, g_final):
    b, n, _ = x.shape
    l_ctx = ctx.shape[1]
    rows = n // GRID_W
    cos, sin = axial_rope(rows)
    for layer in range(DEPTH):
        last = layer == DEPTH - 1
        mod_lat = (jax.nn.silu(c) @ w_mod[layer] + b_mod[layer])[:, None, :]
        mod_ctx = (jax.nn.silu(c_ctx) @ w_mod[layer] + b_mod[layer])[None, None, :]
        sh1, sc1, gt1, sh2, sc2, gt2 = jnp.split(mod_lat, N_MOD, axis=-1)
        csh1, csc1, cgt1, csh2, csc2, cgt2 = jnp.split(mod_ctx, N_MOD, axis=-1)

        h_ctx = modulate(rms_norm(ctx, g_mix[layer]), csh1, csc1)
        if last:
            kv_c = h_ctx @ w_in[layer][:, IN_SPLITS[0]:IN_SPLITS[2]]
            kc, vc = jnp.split(kv_c, 2, axis=-1)
        else:
            qc, kc, vc, uc, vsc, fc, gc = jnp.split(h_ctx @ w_in[layer], IN_SPLITS, axis=-1)
        kc = kc.reshape(b, l_ctx, N_KV_HEADS, HEAD_DIM)
        vc = vc.reshape(b, l_ctx, N_KV_HEADS, HEAD_DIM)
        if not last:
            a_c = context_attention(qc.reshape(b, l_ctx, N_HEADS, HEAD_DIM), kc, vc, attn_sink[layer])
            s_c = chunk_sgu(uc, vsc, w_spatial[layer], b_spatial[layer])
            f_c = fourier_mix(fc)
            ctx_new = ctx + cgt1 * merge_branches(a_c, s_c, f_c, gc, w_branch_attn[layer], w_branch_sgu[layer],
                                                  w_branch_fourier[layer], w_out[layer])
            h2c = modulate(rms_norm(ctx_new, g_ffn[layer]), csh2, csc2)
            ctx_new = ctx_new + cgt2 * expert_choice(h2c, w_router[layer], w_gate[layer], w_up[layer], w_down[layer])

        h = modulate(rms_norm(x, g_mix[layer]), sh1, sc1)
        q, k, v, u, vs, f, gates = jnp.split(h @ w_in[layer], IN_SPLITS, axis=-1)
        q = apply_rope(q.reshape(b, n, N_HEADS, HEAD_DIM), cos, sin)
        k = apply_rope(k.reshape(b, n, N_KV_HEADS, HEAD_DIM), cos, sin)
        v = v.reshape(b, n, N_KV_HEADS, HEAD_DIM)
        a = window_attention(q, k, v, kc, vc, attn_sink[layer])
        s = chunk_sgu(u, vs, w_spatial[layer], b_spatial[layer])
        fo = fourier_mix(f)
        x = x + gt1 * merge_branches(a, s, fo, gates, w_branch_attn[layer], w_branch_sgu[layer],
                                     w_branch_fourier[layer], w_out[layer])
        h2 = modulate(rms_norm(x, g_ffn[layer]), sh2, sc2)
        x = x + gt2 * expert_choice(h2, w_router[layer], w_gate[layer], w_up[layer], w_down[layer])

        if not last:
            ctx = ctx_new
    return rms_norm(x, g_final)
```

```cpp
#include <hip/hip_runtime.h>
#include <cstdio>
#include <cstdint>
#include <type_traits>

#ifndef MK_MULTI
#define MK_MULTI 0
#endif

#define LAS __attribute__((address_space(3)))
#define GAS __attribute__((address_space(1)))
typedef unsigned short bf16_t;
typedef short bf16x8 __attribute__((ext_vector_type(8)));
typedef short s16x4 __attribute__((ext_vector_type(4)));
typedef float f32x2 __attribute__((ext_vector_type(2)));
typedef float f32x4 __attribute__((ext_vector_type(4)));
typedef float f32x16 __attribute__((ext_vector_type(16)));
typedef unsigned u32x4 __attribute__((ext_vector_type(4)));
typedef unsigned u32x2 __attribute__((ext_vector_type(2)));
typedef __bf16 bf16x2_t __attribute__((ext_vector_type(2)));
typedef int v4i_t __attribute__((ext_vector_type(4)));
typedef int v8i_t __attribute__((ext_vector_type(8)));

constexpr int D = 1024, SEQ = 16384, NLAT = 32768, LCTX = 256, NCTX = 512, NR = 33280, DEPTH = 4;
constexpr int INW = 4608, BTIN = 4864, NE = 16, FF = 2048, CAP = 2048, CAPC = 32, EROWS = 4352, ETILES = 17, NEROWS = NE * EROWS;
constexpr int NMOD = 6 * D;
constexpr float EPS = 1e-6f;
constexpr float LOG2E = 1.4426950408889634f;
constexpr int NWAVES = 8, NTHR = 512;

constexpr size_t al256(size_t x) { return (x + 255) & ~(size_t)255; }
constexpr size_t O_CTL = 0, CTL_BYTES = 1u << 20;
constexpr size_t O_MODV = O_CTL + CTL_BYTES;
constexpr size_t O_ROPEC = al256(O_MODV + (size_t)DEPTH * 3 * NMOD * 4);
constexpr size_t O_ROPES = al256(O_ROPEC + (size_t)SEQ * 32 * 4);
constexpr size_t O_TWC = al256(O_ROPES + (size_t)SEQ * 32 * 4);
constexpr size_t O_TWS = al256(O_TWC + 128 * 128 * 4);
constexpr size_t O_TA = al256(O_TWS + 128 * 128 * 4);
constexpr size_t O_TC = al256(O_TA + 256 * 256 * 2);
constexpr size_t O_TX = al256(O_TC + 256 * 256 * 2);
constexpr size_t O_BTIN = al256(O_TX + 256 * 512 * 2);
constexpr size_t SZ_BTIN = (size_t)BTIN * D * 2;
constexpr size_t O_BTBR = al256(O_BTIN + 2 * SZ_BTIN);
constexpr size_t SZ_SQ = (size_t)D * D * 2;
constexpr size_t O_BTO = al256(O_BTBR + 2 * SZ_SQ);
constexpr size_t O_BTGU = al256(O_BTO + 2 * SZ_SQ);
constexpr size_t O_BTD = al256(O_BTGU + (size_t)NE * 4096 * D * 2);
constexpr size_t O_HB = al256(O_BTD + (size_t)NE * D * FF * 2);
constexpr size_t O_QB = al256(O_HB + (size_t)NR * D * 2);
constexpr size_t O_KVB = al256(O_QB + (size_t)NR * 512 * 2);
constexpr size_t O_UB = al256(O_KVB + (size_t)NR * 256 * 2);
constexpr size_t O_VST = al256(O_UB + (size_t)NR * 256 * 2);
constexpr size_t O_GB = al256(O_VST + (size_t)NR * 256 * 2);
constexpr size_t O_GC = al256(O_GB + (size_t)2 * 128 * 256 * 256 * 2);
constexpr size_t O_GATES = al256(O_GC + (size_t)2 * 256 * 512 * 2);
constexpr size_t O_AP = al256(O_GATES + (size_t)NR * 3072 * 2);
constexpr size_t O_CAT = al256(O_AP + (size_t)2 * 128 * 256 * 256 * 2);
constexpr size_t O_MACC = al256(O_CAT + (size_t)NR * D * 2);
constexpr size_t O_MB = al256(O_MACC + (size_t)NR * D * 4);
constexpr size_t O_XW = al256(O_MB + (size_t)NR * D * 2);
constexpr size_t O_AFFL = al256(O_XW + (size_t)NR * D * 4);
constexpr size_t O_AFFC = al256(O_AFFL + (size_t)2 * NE * SEQ * 4);
constexpr size_t O_ROWSEL = al256(O_AFFC + (size_t)2 * NE * LCTX * 4);
constexpr size_t O_GSEL = al256(O_ROWSEL + (size_t)NE * EROWS * 4);
constexpr size_t O_SLOTOF = al256(O_GSEL + (size_t)NE * EROWS * 4);
constexpr size_t O_XE = al256(O_SLOTOF + (size_t)NE * NR * 4);
constexpr size_t O_ACT = al256(O_XE + (size_t)NEROWS * D * 2);
constexpr size_t O_YB = al256(O_ACT + (size_t)NEROWS * FF * 2);
constexpr size_t O_HB8 = al256(O_YB + (size_t)NEROWS * D * 2);
constexpr size_t O_BTG8 = al256(O_HB8 + (size_t)NR * D);
constexpr size_t O_END = al256(O_BTG8 + (size_t)2 * 3072 * D);

constexpr int CW_BAR = 4096;

constexpr int RING_BYTES = 131072;
constexpr int LDS_BYTES = 147456;
constexpr int MISC_OFF = LDS_BYTES - 256;

__device__ __forceinline__ int lane_id() { int l; asm volatile("v_mbcnt_lo_u32_b32 %0, -1, 0\n\tv_mbcnt_hi_u32_b32 %0, -1, %0" : "=v"(l)); return l; }
__device__ __forceinline__ unsigned f2bf(float f) { unsigned u = __builtin_bit_cast(unsigned, f); return (u + 0x7fffu + ((u >> 16) & 1u)) >> 16; }
__device__ __forceinline__ unsigned pk2(float lo, float hi) { f32x2 v = {lo, hi}; bf16x2_t b = __builtin_convertvector(v, bf16x2_t); return __builtin_bit_cast(unsigned, b); }
__device__ __forceinline__ unsigned pk4_fp8(float a, float b, float c, float d) { int w = 0; w = __builtin_amdgcn_cvt_pk_fp8_f32(a, b, w, false); w = __builtin_amdgcn_cvt_pk_fp8_f32(c, d, w, true); return (unsigned)w; }
__device__ __forceinline__ unsigned pk4_u8(f32x4 g) { unsigned q[4];
#pragma unroll
    for (int i = 0; i < 4; ++i) { q[i] = (unsigned)(g[i] * 255.0f + 0.5f); q[i] = q[i] < 1u ? 1u : (q[i] > 255u ? 255u : q[i]); }
    return q[0] | (q[1] << 8) | (q[2] << 16) | (q[3] << 24); }
__device__ __forceinline__ f32x4 u8x4_f(unsigned w) { return (f32x4){(float)(w & 0xffu), (float)((w >> 8) & 0xffu), (float)((w >> 16) & 0xffu), (float)(w >> 24)}; }
__device__ __forceinline__ float bflo(unsigned w) { return __builtin_bit_cast(float, w << 16); }
__device__ __forceinline__ float bfhi(unsigned w) { return __builtin_bit_cast(float, w & 0xffff0000u); }
__device__ __forceinline__ float wave_sum(float v) {
#pragma unroll
    for (int o = 1; o < 64; o <<= 1) v += __shfl_xor(v, o);
    return v;
}
__device__ __forceinline__ float fast_sigmoid(float z) { return __builtin_amdgcn_rcpf(1.0f + __builtin_amdgcn_exp2f(-z * LOG2E)); }
__device__ __forceinline__ float gelu_tanh(float x) { const float z = 1.5957691216057308f * (x + 0.044715f * x * x * x); return x * fast_sigmoid(z); }
__device__ __forceinline__ f32x4 gelu4(f32x4 v) { return (f32x4){gelu_tanh(v[0]), gelu_tanh(v[1]), gelu_tanh(v[2]), gelu_tanh(v[3])}; }
__device__ __forceinline__ f32x4 sigm4(f32x4 v) { return (f32x4){fast_sigmoid(v[0]), fast_sigmoid(v[1]), fast_sigmoid(v[2]), fast_sigmoid(v[3])}; }
__device__ __forceinline__ u32x4 pack8(f32x4 a, f32x4 b) { return (u32x4){pk2(a[0], a[1]), pk2(a[2], a[3]), pk2(b[0], b[1]), pk2(b[2], b[3])}; }

#ifndef PG8_SP2
#define PG8_SP2 0
#endif
namespace pg8 {
constexpr int BM = 256, BK = 64, HALF = 128, HTB = HALF * BK * 2, STAGE_BYTES = 8 * HTB;
__host__ __device__ __forceinline__ int lds_byte(int r, int c) { const int st = (r >> 4) * 2 + (c >> 5), rr = r & 15, cc = c & 31, ob = rr * 64 + cc * 2; return st * 1024 + (ob ^ (((ob >> 9) & 1) << 5)); }
__host__ __device__ __forceinline__ void stage_rc(int b, int& R, int& C) { const int st = b / 1024, sb = b % 1024, swz = sb ^ (((sb >> 9) & 1) << 5); R = (st >> 1) * 16 + swz / 64; C = (st & 1) * 32 + (swz % 64) / 2; }
__host__ __device__ __forceinline__ int perm32(int rho) { const int n = rho >> 4, i = rho & 15; return 8 * (i >> 2) + 4 * n + (i & 3); }

struct Unit { const char* A; const char* B; int nt; int pm, pn, aux; };
struct Geom { int lda, ldb; unsigned hstepA, hstepB; };

template <class Epi, class Sched, bool F8 = false>
__device__ __forceinline__ void gemm_phase(LAS unsigned char* lds, const int wave, const Geom g, const Sched& S, const Epi& E) {
    int tid_ = wave * 64 + lane_id(); asm volatile("" : "+v"(tid_));
    const int tid = tid_, wid = __builtin_amdgcn_readfirstlane(tid >> 6), lane = tid & 63, wr = wid >> 2, wc = wid & 3, fr = lane & 15, fq = lane >> 4;
    unsigned voffA[2], voffB[2];
#pragma unroll
    for (int i = 0; i < 2; ++i) { int R, C; stage_rc(tid * 16 + i * 8192, R, C); const int Rb = Epi::PERM ? ((R & ~31) + perm32(R & 31)) : R;
        voffA[i] = (unsigned)(R * g.lda + C) * 2u; voffB[i] = (unsigned)(Rb * g.ldb + C) * 2u; }
    const size_t kstep = (size_t)(BK * 2);
    const size_t hstepA = g.hstepA, hstepB = g.hstepB;
    const unsigned ldsw = (unsigned)wid * 1024u;
    const int aoff = lds_byte(wr * 64 + fr, fq * 8), boff = lds_byte(wc * 32 + fr, fq * 8);
#define PG8_SA(b, h) (((b) * 2 + (h)) * HTB)
#define PG8_SB(b, h) ((4 + (b) * 2 + (h)) * HTB)
#define PG8_STAGE(bufoff, gbase, voff) do { _Pragma("unroll") for (int _i = 0; _i < 2; ++_i) \
        __builtin_amdgcn_global_load_lds((const unsigned*)((const char*)(gbase) + (voff)[_i]), (LAS unsigned*)(lds + (bufoff) + ldsw + _i * 8192), 16, 0, 0); } while (0)
#define PG8_LD1(dst, off) do { if constexpr (F8) { const v4i_t lo_ = *(const LAS v4i_t*)(lds + (off)), hi_ = *(const LAS v4i_t*)(lds + (off) + 1024); (dst)[0] = __builtin_shufflevector(lo_, hi_, 0, 1, 2, 3, 4, 5, 6, 7); } \
        else { _Pragma("unroll") for (int k = 0; k < 2; ++k) (dst)[k] = *(const LAS frag_t*)(lds + (off) + k * 1024); } } while (0)
#define PG8_LDA(dst, b, h) do { _Pragma("unroll") for (int m = 0; m < 4; ++m) PG8_LD1(dst[m], PG8_SA(b, h) + aoff + m * 2048); } while (0)
#define PG8_LDB(dst, b, h) do { _Pragma("unroll") for (int n = 0; n < 2; ++n) PG8_LD1(dst[n], PG8_SB(b, h) + boff + n * 2048); } while (0)
#define PG8_MMA(ai, bj, At, Bt) do { __builtin_amdgcn_s_setprio(1); \
        if constexpr (F8) { _Pragma("unroll") for (int m = 0; m < 4; ++m) _Pragma("unroll") for (int n = 0; n < 2; ++n) \
            asm volatile("v_mfma_f32_16x16x128_f8f6f4 %0, %1, %2, %0" : "+v"(acc[ai][bj][m][n]) : "v"(Bt[n][0]), "v"(At[m][0])); } \
        else { _Pragma("unroll") for (int m = 0; m < 4; ++m) _Pragma("unroll") for (int n = 0; n < 2; ++n) _Pragma("unroll") for (int k = 0; k < 2; ++k) \
            acc[ai][bj][m][n] = __builtin_amdgcn_mfma_f32_16x16x32_bf16(Bt[n][k], At[m][k], acc[ai][bj][m][n], 0, 0, 0); } \
        __builtin_amdgcn_s_setprio(0); } while (0)
#define PG8_WAIT_V(n) asm volatile("s_waitcnt vmcnt(" #n ")" ::: "memory")
#define PG8_WAIT_L(n) asm volatile("s_waitcnt lgkmcnt(" #n ")" ::: "memory")
#define PG8_BAR __builtin_amdgcn_s_barrier()
#define PG8_SCHED __builtin_amdgcn_sched_barrier(0)
    Unit cur, nxt; int ui = 0;
    if (!S.next(0, cur)) return;
    f32x4 acc[2][2][4][2];
#pragma unroll
    for (int a = 0; a < 2; ++a)
#pragma unroll
        for (int b = 0; b < 2; ++b)
#pragma unroll
            for (int m = 0; m < 4; ++m)
#pragma unroll
                for (int n = 0; n < 2; ++n) acc[a][b][m][n] = (f32x4){0.f, 0.f, 0.f, 0.f};
    typedef typename std::conditional<F8, v8i_t, bf16x8>::type frag_t;
    frag_t At[4][F8 ? 1 : 2], B0[2][F8 ? 1 : 2], B1[2][F8 ? 1 : 2];
    const char* cA = cur.A; const char* cB = cur.B;
#if PG8_SP2
    PG8_STAGE(PG8_SB(0, 0), cB, voffB); PG8_STAGE(PG8_SB(0, 1), cB + hstepB, voffB); PG8_STAGE(PG8_SA(0, 0), cA, voffA); PG8_STAGE(PG8_SA(0, 1), cA + hstepA, voffA);
    if (wr == 1) PG8_BAR;
    PG8_WAIT_V(2); PG8_BAR;
    PG8_STAGE(PG8_SB(1, 0), cB + kstep, voffB); PG8_STAGE(PG8_SA(1, 0), cA + kstep, voffA); PG8_STAGE(PG8_SB(1, 1), cB + hstepB + kstep, voffB);
    PG8_WAIT_V(6); PG8_BAR;
#else
    PG8_STAGE(PG8_SB(0, 0), cB, voffB); PG8_STAGE(PG8_SA(0, 0), cA, voffA); PG8_STAGE(PG8_SB(0, 1), cB + hstepB, voffB); PG8_STAGE(PG8_SA(0, 1), cA + hstepA, voffA);
    if (wr == 1) PG8_BAR;
    PG8_WAIT_V(4); PG8_BAR;
    PG8_STAGE(PG8_SB(1, 0), cB + kstep, voffB); PG8_STAGE(PG8_SA(1, 0), cA + kstep, voffA); PG8_STAGE(PG8_SB(1, 1), cB + hstepB + kstep, voffB);
    PG8_WAIT_V(6); PG8_BAR;
#endif
    for (;;) {
        const bool has_next = S.next(ui + 1, nxt);
        const char* nA = has_next ? nxt.A : cA; const char* nB = has_next ? nxt.B : cB;
        const int nt = cur.nt;
#pragma unroll 1
        for (int t = 0; t < nt; t += 2) {
            const bool last = (t == nt - 2);
            const char* a1 = cA + (size_t)(t + 1) * kstep;
            const char* a2 = last ? nA : cA + (size_t)(t + 2) * kstep; const char* b2 = last ? nB : cB + (size_t)(t + 2) * kstep;
            const char* a3 = a2 + kstep; const char* b3 = b2 + kstep;
#if PG8_SP2
            PG8_LDB(B0, 0, 0); PG8_LDB(B1, 0, 1); PG8_SCHED; PG8_LDA(At, 0, 0); PG8_STAGE(PG8_SA(1, 1), a1 + hstepA, voffA);
            PG8_WAIT_V(8); PG8_WAIT_L(0); PG8_BAR; PG8_MMA(0, 0, At, B0); PG8_MMA(0, 1, At, B1); PG8_BAR; PG8_SCHED;
            PG8_LDA(At, 0, 1); PG8_STAGE(PG8_SB(0, 0), b2, voffB); PG8_STAGE(PG8_SB(0, 1), b2 + hstepB, voffB); PG8_STAGE(PG8_SA(0, 0), a2, voffA);
            PG8_WAIT_V(8); PG8_WAIT_L(0); PG8_BAR; PG8_MMA(1, 0, At, B0); PG8_MMA(1, 1, At, B1); PG8_BAR; PG8_SCHED;
            PG8_LDB(B0, 1, 0); PG8_LDB(B1, 1, 1); PG8_SCHED; PG8_LDA(At, 1, 0); PG8_STAGE(PG8_SA(0, 1), a2 + hstepA, voffA);
            PG8_WAIT_V(8); PG8_WAIT_L(0); PG8_BAR; PG8_MMA(0, 0, At, B0); PG8_MMA(0, 1, At, B1); PG8_BAR; PG8_SCHED;
            PG8_LDA(At, 1, 1); PG8_STAGE(PG8_SB(1, 0), b3, voffB); PG8_STAGE(PG8_SB(1, 1), b3 + hstepB, voffB); PG8_STAGE(PG8_SA(1, 0), a3, voffA);
            PG8_WAIT_V(8); PG8_WAIT_L(0); PG8_BAR; PG8_MMA(1, 0, At, B0); PG8_MMA(1, 1, At, B1); PG8_BAR; PG8_SCHED;
#else
            PG8_LDB(B0, 0, 0); PG8_SCHED; PG8_LDA(At, 0, 0); PG8_STAGE(PG8_SA(1, 1), a1 + hstepA, voffA);
            PG8_WAIT_L(8); PG8_BAR; PG8_WAIT_L(0); PG8_MMA(0, 0, At, B0); PG8_BAR; PG8_SCHED;
            PG8_LDB(B1, 0, 1); PG8_STAGE(PG8_SB(0, 0), b2, voffB);
            PG8_BAR; PG8_WAIT_L(0); PG8_MMA(0, 1, At, B1); PG8_BAR;
            PG8_LDA(At, 0, 1); PG8_STAGE(PG8_SA(0, 0), a2, voffA);
            PG8_BAR; PG8_WAIT_L(0); PG8_MMA(1, 0, At, B0); PG8_BAR; PG8_SCHED;
            PG8_STAGE(PG8_SB(0, 1), b2 + hstepB, voffB);
            PG8_WAIT_V(6); PG8_BAR; PG8_MMA(1, 1, At, B1); PG8_BAR;
            PG8_LDB(B0, 1, 0); PG8_SCHED; PG8_LDA(At, 1, 0); PG8_STAGE(PG8_SA(0, 1), a2 + hstepA, voffA);
            PG8_WAIT_L(8); PG8_BAR; PG8_WAIT_L(0); PG8_MMA(0, 0, At, B0); PG8_BAR; PG8_SCHED;
            PG8_LDB(B1, 1, 1); PG8_STAGE(PG8_SB(1, 0), b3, voffB);
            PG8_BAR; PG8_WAIT_L(0); PG8_MMA(0, 1, At, B1); PG8_BAR;
            PG8_LDA(At, 1, 1); PG8_STAGE(PG8_SA(1, 0), a3, voffA);
            PG8_BAR; PG8_WAIT_L(0); PG8_MMA(1, 0, At, B0); PG8_BAR; PG8_SCHED;
            PG8_STAGE(PG8_SB(1, 1), b3 + hstepB, voffB);
            PG8_WAIT_V(6); PG8_BAR; PG8_MMA(1, 1, At, B1); PG8_BAR;
#endif
        }
        if (wr == 0) PG8_BAR;
        if constexpr (F8) asm volatile("s_nop 15\n\ts_nop 7" ::: "memory");
        { const int l2 = lane_id(); E(acc, cur, wr, wc, l2 & 15, l2 >> 4); }
        if (!has_next) break;
        if (!E.keep(cur)) {
#pragma unroll
        for (int a = 0; a < 2; ++a)
#pragma unroll
            for (int b = 0; b < 2; ++b)
#pragma unroll
                for (int m = 0; m < 4; ++m)
#pragma unroll
                    for (int n = 0; n < 2; ++n) acc[a][b][m][n] = (f32x4){0.f, 0.f, 0.f, 0.f};
        }
        cur = nxt; cA = nA; cB = nB; ++ui;
        if (wr == 1) PG8_BAR;
    }
    PG8_WAIT_V(0);
    PG8_BAR;
#undef PG8_SA
#undef PG8_SB
#undef PG8_STAGE
#undef PG8_LDA
#undef PG8_LDB
#undef PG8_MMA
#undef PG8_LD1
#undef PG8_WAIT_V
#undef PG8_WAIT_L
#undef PG8_BAR
#undef PG8_SCHED
}

struct Deal {
    int nM, nN, nwg, G, c;
    __device__ __forceinline__ void init(int nM_, int nN_, int G_, int blk, int off) { nM = nM_; nN = nN_; nwg = nM_ * nN_; G = G_; c = (blk + G_ - (off % G_)) % G_; }
    __device__ __forceinline__ bool get(int i, int& tm, int& tn) const {
        const long L = (long)i * G + c; if (L >= nwg) return false;
        int w = (int)L; { const int q = nwg / 8, r = nwg % 8, x = w % 8, o = w / 8; w = (x < r ? x * (q + 1) : r * (q + 1) + (x - r) * q) + o; }
        const int nig = 8 * nN, gid = w / nig, fm = gid * 8, gsz = (nM - fm) < 8 ? (nM - fm) : 8;
        tm = fm + ((w % nig) % gsz); tn = (w % nig) / gsz; return true;
    }
};
struct Sch2D {
    Deal d; const char* A; const char* B; size_t sA, sB; int nt;
    __device__ __forceinline__ bool next(int i, Unit& u) const { int tm, tn; if (!d.get(i, tm, tn)) return false; u.A = A + (size_t)tm * sA; u.B = B + (size_t)tn * sB; u.nt = nt; u.pm = tm; u.pn = tn; u.aux = 0; return true; }
};
}
using pg8::Unit;

struct EpiQ {
    static constexpr bool PERM = true;
    bf16_t* Q; const float* rc; const float* rs; float scale;
    __device__ __forceinline__ bool keep(const Unit&) const { return false; }
    __device__ __forceinline__ void operator()(f32x4 (&acc)[2][2][4][2], const Unit& u, int wr, int wc, int fr, int fq) const {
        const int row0 = u.pm * 256 + wr * 64 + fr; const bool lat = u.pm < 128; const int t4 = (4 * (wc & 1) + fq) * 4;
#pragma unroll
        for (int ai = 0; ai < 2; ++ai)
#pragma unroll
            for (int m = 0; m < 4; ++m) { __builtin_amdgcn_sched_barrier(0); const int row = row0 + ai * 128 + m * 16;
                f32x4 c4 = {1.f, 1.f, 1.f, 1.f}, s4 = {0.f, 0.f, 0.f, 0.f};
                if (lat) { const int pos = row & (SEQ - 1); c4 = *(const f32x4*)(rc + pos * 32 + t4); s4 = *(const f32x4*)(rs + pos * 32 + t4); }
#pragma unroll
                for (int bj = 0; bj < 2; ++bj) { const f32x4 x1 = acc[ai][bj][m][0], x2 = acc[ai][bj][m][1];
                    const f32x4 o1 = (x1 * c4 - x2 * s4) * scale, o2 = (x2 * c4 + x1 * s4) * scale;
                    *(u32x4*)(Q + (size_t)row * 512 + u.pn * 256 + bj * 128 + wc * 32 + 8 * fq) = pack8(o1, o2); } }
    }
};
struct EpiKV {
    static constexpr bool PERM = true;
    bf16_t* KV; const float* rc; const float* rs;
    __device__ __forceinline__ bool keep(const Unit&) const { return false; }
    __device__ __forceinline__ void operator()(f32x4 (&acc)[2][2][4][2], const Unit& u, int wr, int wc, int fr, int fq) const {
        const int row0 = u.pm * 256 + wr * 64 + fr; const bool lat = u.pm < 128; const int t4 = (4 * (wc & 1) + fq) * 4;
#pragma unroll
        for (int ai = 0; ai < 2; ++ai)
#pragma unroll
            for (int m = 0; m < 4; ++m) { __builtin_amdgcn_sched_barrier(0); const int row = row0 + ai * 128 + m * 16;
                f32x4 c4 = {1.f, 1.f, 1.f, 1.f}, s4 = {0.f, 0.f, 0.f, 0.f};
                if (lat) { const int pos = row & (SEQ - 1); c4 = *(const f32x4*)(rc + pos * 32 + t4); s4 = *(const f32x4*)(rs + pos * 32 + t4); }
                { const f32x4 x1 = acc[ai][0][m][0], x2 = acc[ai][0][m][1];
                  *(u32x4*)(KV + (size_t)row * 256 + wc * 32 + 8 * fq) = pack8(x1 * c4 - x2 * s4, x2 * c4 + x1 * s4); }
                *(u32x4*)(KV + (size_t)row * 256 + 128 + wc * 32 + 8 * fq) = pack8(acc[ai][1][m][0], acc[ai][1][m][1]); }
    }
};
struct EpiQKVU {
    static constexpr bool PERM = true;
    bf16_t* Q; bf16_t* KV; bf16_t* U; const float* rc; const float* rs; float scale;
    __device__ __forceinline__ bool keep(const Unit&) const { return false; }
    __device__ __forceinline__ void operator()(f32x4 (&acc)[2][2][4][2], const Unit& u, int wr, int wc, int fr, int fq) const {
        const int row0 = u.pm * 256 + wr * 64 + fr; const bool lat = u.pm < 128; const int t4 = (4 * (wc & 1) + fq) * 4; const int kind = u.pn;
#pragma unroll
        for (int ai = 0; ai < 2; ++ai)
#pragma unroll
            for (int m = 0; m < 4; ++m) { __builtin_amdgcn_sched_barrier(0); const int row = row0 + ai * 128 + m * 16;
                if (kind == 3) {
#pragma unroll
                    for (int bj = 0; bj < 2; ++bj) *(u32x4*)(U + (size_t)row * 256 + bj * 128 + wc * 32 + 8 * fq) = pack8(gelu4(acc[ai][bj][m][0]), gelu4(acc[ai][bj][m][1]));
                } else {
                    f32x4 c4 = {1.f, 1.f, 1.f, 1.f}, s4 = {0.f, 0.f, 0.f, 0.f};
                    if (lat) { const int pos = row & (SEQ - 1); c4 = *(const f32x4*)(rc + pos * 32 + t4); s4 = *(const f32x4*)(rs + pos * 32 + t4); }
                    if (kind < 2) {
#pragma unroll
                        for (int bj = 0; bj < 2; ++bj) { const f32x4 x1 = acc[ai][bj][m][0], x2 = acc[ai][bj][m][1];
                            *(u32x4*)(Q + (size_t)row * 512 + kind * 256 + bj * 128 + wc * 32 + 8 * fq) = pack8((x1 * c4 - x2 * s4) * scale, (x2 * c4 + x1 * s4) * scale); }
                    } else {
                        const f32x4 x1 = acc[ai][0][m][0], x2 = acc[ai][0][m][1];
                        *(u32x4*)(KV + (size_t)row * 256 + wc * 32 + 8 * fq) = pack8(x1 * c4 - x2 * s4, x2 * c4 + x1 * s4);
                        *(u32x4*)(KV + (size_t)row * 256 + 128 + wc * 32 + 8 * fq) = pack8(acc[ai][1][m][0], acc[ai][1][m][1]); } } }
    }
};
template <int ACT> struct EpiAct {
    static constexpr bool PERM = true;
    bf16_t* O; int ldc; float scale;
    __device__ __forceinline__ bool keep(const Unit&) const { return false; }
    __device__ __forceinline__ void operator()(f32x4 (&acc)[2][2][4][2], const Unit& u, int wr, int wc, int fr, int fq) const {
        const int row0 = u.pm * 256 + wr * 64 + fr;
#pragma unroll
        for (int ai = 0; ai < 2; ++ai)
#pragma unroll
            for (int m = 0; m < 4; ++m) { __builtin_amdgcn_sched_barrier(0); bf16_t* rowp = O + (size_t)(row0 + ai * 128 + m * 16) * ldc + u.pn * 256 + wc * 32 + 8 * fq;
#pragma unroll
                for (int bj = 0; bj < 2; ++bj) { f32x4 v0 = acc[ai][bj][m][0], v1 = acc[ai][bj][m][1];
                    if (ACT == 0) { v0 = gelu4(v0); v1 = gelu4(v1); }
                    if (ACT == 1) { v0 = sigm4(v0); v1 = sigm4(v1); }
                    if (ACT == 3) { v0 *= scale; v1 *= scale; }
                    if (ACT == 5) { v0 *= scale; v1 *= scale;
                        *(u32x2*)((unsigned char*)O + (size_t)(row0 + ai * 128 + m * 16) * ldc + u.pn * 256 + wc * 32 + 8 * fq + bj * 128) = (u32x2){pk4_fp8(v0[0], v0[1], v0[2], v0[3]), pk4_fp8(v1[0], v1[1], v1[2], v1[3])}; continue; }
                    if (ACT == 4) { v0 = sigm4(v0 * scale); v1 = sigm4(v1 * scale);
                        *(u32x2*)((unsigned char*)O + (size_t)(row0 + ai * 128 + m * 16) * ldc + u.pn * 256 + wc * 32 + 8 * fq + bj * 128) = (u32x2){pk4_u8(v0), pk4_u8(v1)}; continue; }
                    *(u32x4*)(rowp + bj * 128) = pack8(v0, v1); } }
    }
};
struct EpiVsT {
    static constexpr bool PERM = true;
    bf16_t* VST;
    __device__ __forceinline__ bool keep(const Unit&) const { return false; }
    __device__ __forceinline__ void operator()(f32x4 (&acc)[2][2][4][2], const Unit& u, int wr, int wc, int fr, int fq) const {
#pragma unroll
        for (int ai = 0; ai < 2; ++ai)
#pragma unroll
            for (int bj = 0; bj < 2; ++bj)
#pragma unroll
                for (int n = 0; n < 2; ++n) { __builtin_amdgcn_sched_barrier(0);
                    f32x4 g[4]; f32x4 ss = {0.f, 0.f, 0.f, 0.f};
#pragma unroll
                    for (int m = 0; m < 4; ++m) { g[m] = gelu4(acc[ai][bj][m][n]); ss += g[m] * g[m]; }
#pragma unroll
                    for (int i = 0; i < 4; ++i) { float q = ss[i]; q += __shfl_xor(q, 1); q += __shfl_xor(q, 2); q += __shfl_xor(q, 4); q += __shfl_xor(q, 8);
                        ss[i] = __builtin_amdgcn_rsqf(q * (1.0f / 64.0f) + EPS); }
                    const size_t grow = (size_t)u.pn * 256 + bj * 128 + wc * 32 + 8 * fq + 4 * n;
#pragma unroll
                    for (int m = 0; m < 4; ++m) { const int ch = ai * 128 + wr * 64 + m * 16 + fr; const f32x4 y = g[m] * ss;
                        *(u32x2*)(VST + (size_t)ch * NR + grow) = (u32x2){pk2(y[0], y[1]), pk2(y[2], y[3])}; } }
    }
};
struct EpiFG {
    static constexpr bool PERM = true;
    bf16_t* G;
    __device__ __forceinline__ bool keep(const Unit&) const { return false; }
    __device__ __forceinline__ void operator()(f32x4 (&acc)[2][2][4][2], const Unit& u, int wr, int wc, int fr, int fq) const {
        const int b = u.aux >> 6, jp = u.aux & 63, rip = u.pm;
#pragma unroll
        for (int ai = 0; ai < 2; ++ai)
#pragma unroll
            for (int m = 0; m < 4; ++m) { __builtin_amdgcn_sched_barrier(0); const int gm = ai * 128 + wr * 64 + m * 16 + fr;
#pragma unroll
                for (int bj = 0; bj < 2; ++bj) { const int n2 = 2 * jp + bj;
                    *(u32x4*)(G + ((((size_t)(b * 128 + n2) * 256 + gm) * 2 + rip) * 128 + wc * 32 + 8 * fq)) = pack8(acc[ai][bj][m][0], acc[ai][bj][m][1]); } }
    }
};
struct EpiFGc {
    static constexpr bool PERM = true;
    bf16_t* Gc;
    __device__ __forceinline__ bool keep(const Unit&) const { return false; }
    __device__ __forceinline__ void operator()(f32x4 (&acc)[2][2][4][2], const Unit& u, int wr, int wc, int fr, int fq) const {
        const int b = u.aux, rip = u.pm;
#pragma unroll
        for (int ai = 0; ai < 2; ++ai)
#pragma unroll
            for (int m = 0; m < 4; ++m) { __builtin_amdgcn_sched_barrier(0); const int gm = ai * 128 + wr * 64 + m * 16 + fr;
#pragma unroll
                for (int bj = 0; bj < 2; ++bj)
                    *(u32x4*)(Gc + (((size_t)(b * 256 + gm) * 2 + rip) * 256 + bj * 128 + wc * 32 + 8 * fq)) = pack8(acc[ai][bj][m][0], acc[ai][bj][m][1]); }
    }
};
struct EpiDftA {
    static constexpr bool PERM = true;
    bf16_t* AP; const float* twc; const float* tws;
    __device__ __forceinline__ bool keep(const Unit&) const { return false; }
    __device__ __forceinline__ void operator()(f32x4 (&acc)[2][2][4][2], const Unit& u, int wr, int wc, int fr, int fq) const {
        const int b = u.aux >> 7, jp = u.aux & 127;
#pragma unroll
        for (int m = 0; m < 4; ++m) { __builtin_amdgcn_sched_barrier(0); const int k1 = wr * 64 + m * 16 + fr; const int n2 = wc * 32 + 8 * fq;
            const f32x4 c0 = *(const f32x4*)(twc + k1 * 128 + n2), c1 = *(const f32x4*)(twc + k1 * 128 + n2 + 4);
            const f32x4 s0 = *(const f32x4*)(tws + k1 * 128 + n2), s1 = *(const f32x4*)(tws + k1 * 128 + n2 + 4);
#pragma unroll
            for (int bj = 0; bj < 2; ++bj) { const int gm = 2 * jp + bj;
                const f32x4 re0 = acc[0][bj][m][0], re1 = acc[0][bj][m][1], im0 = acc[1][bj][m][0], im1 = acc[1][bj][m][1];
                bf16_t* p = AP + (((size_t)(b * 128 + k1) * 256 + gm) * 2) * 128 + n2;
                *(u32x4*)(p) = pack8(re0 * c0 + im0 * s0, re1 * c1 + im1 * s1);
                *(u32x4*)(p + 128) = pack8(im0 * c0 - re0 * s0, im1 * c1 - re1 * s1); }
            asm volatile("" ::: "memory"); }
    }
};
struct EpiDftC {
    static constexpr bool PERM = true;
    bf16_t* CAT;
    __device__ __forceinline__ bool keep(const Unit&) const { return false; }
    __device__ __forceinline__ void operator()(f32x4 (&acc)[2][2][4][2], const Unit& u, int wr, int wc, int fr, int fq) const {
        const int b = u.aux >> 7, k1 = u.aux & 127;
#pragma unroll
        for (int m = 0; m < 4; ++m) { __builtin_amdgcn_sched_barrier(0); const int k2 = wr * 64 + m * 16 + fr; const size_t row = (size_t)b * SEQ + k1 + 128 * k2;
#pragma unroll
            for (int bj = 0; bj < 2; ++bj) *(u32x4*)(CAT + row * D + 768 + bj * 128 + wc * 32 + 8 * fq) = pack8(acc[0][bj][m][0], acc[0][bj][m][1]); }
    }
};
struct EpiDftX {
    static constexpr bool PERM = true;
    bf16_t* CAT;
    __device__ __forceinline__ bool keep(const Unit&) const { return false; }
    __device__ __forceinline__ void operator()(f32x4 (&acc)[2][2][4][2], const Unit& u, int wr, int wc, int fr, int fq) const {
        const int b = u.aux;
#pragma unroll
        for (int ai = 0; ai < 2; ++ai)
#pragma unroll
            for (int m = 0; m < 4; ++m) { __builtin_amdgcn_sched_barrier(0); const size_t row = (size_t)NLAT + b * 256 + ai * 128 + wr * 64 + m * 16 + fr;
#pragma unroll
                for (int bj = 0; bj < 2; ++bj) *(u32x4*)(CAT + row * D + 768 + bj * 128 + wc * 32 + 8 * fq) = pack8(acc[ai][bj][m][0], acc[ai][bj][m][1]); }
    }
};
struct EpiMerge {
    static constexpr bool PERM = true;
    const unsigned char* GATES; bf16_t* MB;
    __device__ __forceinline__ bool keep(const Unit& u) const { return u.aux < 2; }
    __device__ __forceinline__ void operator()(f32x4 (&acc)[2][2][4][2], const Unit& u, int wr, int wc, int fr, int fq) const {
        const int br = u.aux; const int col0 = u.pn * 256 + wc * 32 + 8 * fq;
        const unsigned char* gp = GATES + (size_t)(u.pm * 256 + wr * 64 + fr) * 3072 + br * 1024 + col0;
        u32x2 gc[2], hc[2], gn[2], hn[2];
        gc[0] = *(const u32x2*)(gp); gc[1] = *(const u32x2*)(gp + 128); hc[0] = gc[0]; hc[1] = gc[1];
        if (br < 2) { hc[0] = *(const u32x2*)(gp + 1024); hc[1] = *(const u32x2*)(gp + 1024 + 128); }
#pragma unroll
        for (int grp = 0; grp < 8; ++grp) { const int ai = grp >> 2, m = grp & 3;
            if (grp < 7) { const unsigned char* np = gp + (size_t)(((grp + 1) >> 2) * 128 + ((grp + 1) & 3) * 16) * 3072;
                gn[0] = *(const u32x2*)(np); gn[1] = *(const u32x2*)(np + 128); hn[0] = gn[0]; hn[1] = gn[1];
                if (br < 2) { hn[0] = *(const u32x2*)(np + 1024); hn[1] = *(const u32x2*)(np + 1024 + 128); } }
            const size_t row = (size_t)(u.pm * 256 + wr * 64 + fr + ai * 128 + m * 16);
#pragma unroll
            for (int bj = 0; bj < 2; ++bj) { f32x4 g0 = u8x4_f(gc[bj][0]), g1 = u8x4_f(gc[bj][1]);
                if (br < 2) { const f32x4 h0 = u8x4_f(hc[bj][0]), h1 = u8x4_f(hc[bj][1]);
#pragma unroll
                    for (int i = 0; i < 4; ++i) { g0[i] *= __builtin_amdgcn_rcpf(h0[i]); g1[i] *= __builtin_amdgcn_rcpf(h1[i]); }
                    acc[ai][bj][m][0] *= g0; acc[ai][bj][m][1] *= g1; }
                else *(u32x4*)(MB + row * D + col0 + bj * 128) = pack8(acc[ai][bj][m][0] * (g0 * (1.0f / 255.0f)), acc[ai][bj][m][1] * (g1 * (1.0f / 255.0f))); }
            gc[0] = gn[0]; gc[1] = gn[1]; hc[0] = hn[0]; hc[1] = hn[1];
            __builtin_amdgcn_sched_barrier(0); }
    }
};
struct EpiOut {
    static constexpr bool PERM = true;
    const float* src32; bf16_t* XWb; const float* modv; int layer0;
    __device__ __forceinline__ bool keep(const Unit&) const { return false; }
    __device__ __forceinline__ void operator()(f32x4 (&acc)[2][2][4][2], const Unit& u, int wr, int wc, int fr, int fq) const {
        const int row0 = u.pm * 256 + wr * 64 + fr, col0 = u.pn * 256 + wc * 32 + 8 * fq;
        const float* gt = modv + (u.pm < 64 ? 0 : u.pm < 128 ? 1 : 2) * NMOD + 2 * D + col0;
        f32x4 g[2][2];
#pragma unroll
        for (int bj = 0; bj < 2; ++bj) { g[bj][0] = *(const f32x4*)(gt + bj * 128); g[bj][1] = *(const f32x4*)(gt + bj * 128 + 4); }
        if (layer0) {
#pragma unroll
            for (int ai = 0; ai < 2; ++ai)
#pragma unroll
                for (int m = 0; m < 4; ++m) { __builtin_amdgcn_sched_barrier(0); const size_t ro = (size_t)(row0 + ai * 128 + m * 16) * D + col0;
#pragma unroll
                    for (int bj = 0; bj < 2; ++bj) { const f32x4 x0 = *(const f32x4*)(src32 + ro + bj * 128), x1 = *(const f32x4*)(src32 + ro + bj * 128 + 4);
                        *(u32x4*)(XWb + ro + bj * 128) = pack8(x0 + g[bj][0] * acc[ai][bj][m][0], x1 + g[bj][1] * acc[ai][bj][m][1]); } }
        } else {
            u32x4 xc[2], xn[2];
            { const bf16_t* p = XWb + (size_t)row0 * D + col0; xc[0] = *(const u32x4*)(p); xc[1] = *(const u32x4*)(p + 128); }
#pragma unroll
            for (int grp = 0; grp < 8; ++grp) { const int ai = grp >> 2, m = grp & 3;
                if (grp < 7) { const bf16_t* np = XWb + (size_t)(row0 + ((grp + 1) >> 2) * 128 + ((grp + 1) & 3) * 16) * D + col0; xn[0] = *(const u32x4*)(np); xn[1] = *(const u32x4*)(np + 128); }
                bf16_t* dst = XWb + (size_t)(row0 + ai * 128 + m * 16) * D + col0;
#pragma unroll
                for (int bj = 0; bj < 2; ++bj) { const u32x4 w = xc[bj];
                    const f32x4 x0 = {bflo(w[0]), bfhi(w[0]), bflo(w[1]), bfhi(w[1])}, x1 = {bflo(w[2]), bfhi(w[2]), bflo(w[3]), bfhi(w[3])};
                    *(u32x4*)(dst + bj * 128) = pack8(x0 + g[bj][0] * acc[ai][bj][m][0], x1 + g[bj][1] * acc[ai][bj][m][1]); }
                xc[0] = xn[0]; xc[1] = xn[1];
                __builtin_amdgcn_sched_barrier(0); }
        }
    }
};
struct EpiFfn1 {
    static constexpr bool PERM = true;
    bf16_t* ACT;
    __device__ __forceinline__ bool keep(const Unit&) const { return false; }
    __device__ __forceinline__ void operator()(f32x4 (&acc)[2][2][4][2], const Unit& u, int wr, int wc, int fr, int fq) const {
        const int row0 = u.pm * 256 + wr * 64 + fr;
#pragma unroll
        for (int ai = 0; ai < 2; ++ai)
#pragma unroll
            for (int m = 0; m < 4; ++m) { __builtin_amdgcn_sched_barrier(0); const size_t row = (size_t)(row0 + ai * 128 + m * 16);
                f32x4 o[2];
#pragma unroll
                for (int n = 0; n < 2; ++n) { const f32x4 a = acc[ai][0][m][n] * 0.03125f, up = acc[ai][1][m][n] * 0.03125f; o[n] = a * sigm4(a) * up; }
                o[0] *= 8.0f; o[1] *= 8.0f;
                *(u32x2*)((unsigned char*)ACT + row * FF + u.pn * 128 + wc * 32 + 8 * fq) = (u32x2){pk4_fp8(o[0][0], o[0][1], o[0][2], o[0][3]), pk4_fp8(o[1][0], o[1][1], o[1][2], o[1][3])}; }
    }
};
typedef EpiAct<5> EpiStoreScaled;

#define XB_TMO      128
#define XB_XCNT(j)  (256  + 64 * (j))
#define XB_XSUB(j)  (1280 + 64 * (j))
#define XB_XGEN(j)  (2304 + 64 * (j))
#define XB_TOP      3328
#define XB_TOPGEN   3392
#define XCD_BAR_WORDS 3456
#define XB_SPIN_CAP (1u << 18)
__device__ __forceinline__ unsigned xb_ld(unsigned* p)              { return __hip_atomic_load(p, __ATOMIC_RELAXED, __HIP_MEMORY_SCOPE_AGENT); }
__device__ __forceinline__ unsigned xb_add(unsigned* p, unsigned v) { return __hip_atomic_fetch_add(p, v, __ATOMIC_RELAXED, __HIP_MEMORY_SCOPE_AGENT); }
__device__ __forceinline__ unsigned xb_xcc_id() { return (unsigned)__builtin_amdgcn_s_getreg((3 << 11) | 20) & 0xFu; }
#define XB_SPIN(cond, bar) do { unsigned _sp = 0; while (cond) { __builtin_amdgcn_s_sleep(1); \
    if ((++_sp & 255u) == 0u) { if (xb_ld(&(bar)[XB_TMO])) break; if (_sp > XB_SPIN_CAP) { atomicAdd(&(bar)[XB_TMO], 1u); break; } } } } while (0)
struct XcdBarrier { unsigned* bar; unsigned x; volatile LAS unsigned* st; };
__device__ __forceinline__ XcdBarrier xcd_barrier_post(unsigned* bar, volatile LAS unsigned* st) {
    XcdBarrier b; b.bar = bar; b.x = xb_xcc_id(); b.st = st;
    if (threadIdx.x == 0) (void)xb_add(&bar[XB_XCNT(b.x)], 1u);
    return b;
}
__device__ __forceinline__ void xcd_barrier_complete(unsigned* bar, unsigned x, unsigned& nloc, unsigned& nx) {
    const unsigned G = gridDim.x * gridDim.y * gridDim.z;
    unsigned sum, cnt, mine, sp = 0u;
    for (;;) {
        sum = 0u; cnt = 0u; mine = 0u;
#pragma unroll
        for (unsigned j = 0; j < 16; ++j) { const unsigned c = xb_ld(&bar[XB_XCNT(j)]); sum += c; cnt += (c > 0u) ? 1u : 0u; mine = (j == x) ? c : mine; }
        if (sum == G) break;
        __builtin_amdgcn_s_sleep(1);
        if ((++sp & 255u) == 0u) { if (xb_ld(&bar[XB_TMO])) break; if (sp > XB_SPIN_CAP) { atomicAdd(&bar[XB_TMO], 1u); break; } }
    }
    nloc = mine > 0u ? mine : 1u; nx = cnt > 0u ? cnt : 1u;
}
__device__ __forceinline__ void xcd_barrier(const XcdBarrier& b, const int wave) {
    const bool t0 = (wave == 0) && (lane_id() == 0);
    asm volatile("s_waitcnt vmcnt(0)" ::: "memory");
    __syncthreads();
    if (t0) {
        unsigned* bar = b.bar;
        __builtin_amdgcn_s_waitcnt(0);
        unsigned nloc = b.st[0], nx = b.st[1];
        if (nloc == 0u) { xcd_barrier_complete(bar, b.x, nloc, nx); b.st[0] = nloc; b.st[1] = nx; }
        const unsigned old = xb_add(&bar[XB_XSUB(b.x)], 1u);
        const unsigned gen = old / nloc;
        if (old + 1u == (gen + 1u) * nloc) {
            __builtin_amdgcn_fence(__ATOMIC_RELEASE, "agent");
            asm volatile("s_waitcnt vmcnt(0)" ::: "memory");
            const unsigned og = xb_add(&bar[XB_TOP], 1u);
            const unsigned tg = og / nx;
            if (og + 1u == (tg + 1u) * nx) xb_add(&bar[XB_TOPGEN], 1u);
            else XB_SPIN(xb_ld(&bar[XB_TOPGEN]) == tg, bar);
            __builtin_amdgcn_fence(__ATOMIC_ACQUIRE, "agent");
            xb_add(&bar[XB_XGEN(b.x)], 1u);
            asm volatile("s_waitcnt vmcnt(0)" ::: "memory");
        } else {
            XB_SPIN(xb_ld(&bar[XB_XGEN(b.x)]) == gen, bar);
            __builtin_amdgcn_fence(__ATOMIC_ACQUIRE, "agent");
            asm volatile("s_waitcnt vmcnt(0)" ::: "memory");
        }
    }
    __syncthreads();
}

constexpr int CW_CNT = 8192;
__device__ __forceinline__ void wg_signal(unsigned* cnt, const int wave) {
    asm volatile("s_waitcnt vmcnt(0)" ::: "memory"); __syncthreads();
    if (wave == 0 && lane_id() == 0) { __builtin_amdgcn_fence(__ATOMIC_RELEASE, "agent"); asm volatile("s_waitcnt vmcnt(0)" ::: "memory"); (void)xb_add(cnt, 1u); }
}
__device__ __forceinline__ void wg_wait(unsigned* cnt, unsigned need, const int wave) {
    if (wave == 0 && lane_id() == 0) { unsigned sp = 0; while (xb_ld(cnt) < need) { __builtin_amdgcn_s_sleep(2); if (++sp > (1u << 22)) break; }
        __builtin_amdgcn_fence(__ATOMIC_ACQUIRE, "agent"); asm volatile("s_waitcnt vmcnt(0)" ::: "memory"); }
    __syncthreads();
}

struct Args {
    const float* in[21];
    float* out; unsigned char* ws;
    int ph_lo, ph_hi;
};
struct Frame {
    LAS unsigned char* lds;
    int tid, lane, wave, G, blk;
    unsigned char* ws;
};


#define AS4 __attribute__((address_space(4)))
__device__ __forceinline__ const float* ldin(int i) { const char AS4* ka = (const char AS4*)__builtin_amdgcn_kernarg_segment_ptr(); asm volatile("" : "+s"(ka)); const float GAS* g = *(const float GAS* const AS4*)(ka + 8 * i); asm volatile("" : "+s"(g)); return (const float*)g; }
__device__ __forceinline__ float* ldout() { const char AS4* ka = (const char AS4*)__builtin_amdgcn_kernarg_segment_ptr(); asm volatile("" : "+s"(ka)); float GAS* g = *(float GAS* const AS4*)(ka + 8 * 21); asm volatile("" : "+s"(g)); return (float*)g; }
__device__ __forceinline__ unsigned char* opq(unsigned char* p) { GAS unsigned char* g = (GAS unsigned char*)p; asm volatile("" : "+s"(g)); return (unsigned char*)g; }

__device__ __forceinline__ int headperm(int n) { const int h = n & ~63, i = n & 63; return h + (i < 32 ? 8 * (i >> 2) + (i & 3) : 8 * ((i - 32) >> 2) + 4 + (i & 3)); }
template <int MODE> __device__ __forceinline__ int maprow(int n, int roff) {
    if (MODE == 0) return n + roff;
    if (MODE == 1) { if (n < 640) return headperm(n); if (n < 1280) return n; if (n < 1536) return -1; return n + 256; }
    if (MODE == 2) return (n >> 7) * 256 + (n & 127);
    return (n >> 7) * 256 + 128 + (n & 127);
}
template <int MODE> __device__ __forceinline__ void xpose_item(const float* W, int N, bf16_t* WT, int ldt, int koff, int roff, LAS float* scr, int item, int lane, unsigned char* W8 = nullptr) {
    const int nblk = N / 32, kb = item / nblk, nb = item % nblk, k0 = 64 * kb, n0 = 32 * nb;
    if (MODE == 1 && n0 >= 1280 && n0 < 1536) return;
    { const int lr = lane >> 3, lc = (lane & 7) * 4; f32x4 R[8];
#pragma unroll
      for (int i = 0; i < 8; ++i) R[i] = *(const f32x4*)(W + (size_t)(k0 + lr + 8 * i) * N + n0 + lc);
#pragma unroll
      for (int i = 0; i < 8; ++i) { LAS float* p = scr + (lr + 8 * i) * 33 + lc; p[0] = R[i][0]; p[1] = R[i][1]; p[2] = R[i][2]; p[3] = R[i][3]; } }
    asm volatile("s_waitcnt lgkmcnt(0)" ::: "memory");
    const int c = lane & 7;
#pragma unroll
    for (int j = 0; j < 4; ++j) { const int n = (lane >> 3) + 8 * j; const LAS float* s = scr + (8 * c) * 33 + n;
        if (MODE == 1 && n0 >= 1536) {
            *(u32x2*)(W8 + (size_t)(n0 + n - 1536) * 1024 + k0 + 8 * c) = (u32x2){pk4_fp8(s[0 * 33] * 32.0f, s[1 * 33] * 32.0f, s[2 * 33] * 32.0f, s[3 * 33] * 32.0f), pk4_fp8(s[4 * 33] * 32.0f, s[5 * 33] * 32.0f, s[6 * 33] * 32.0f, s[7 * 33] * 32.0f)};
            continue; }
        u32x4 o; o.x = pk2(s[0 * 33], s[1 * 33]); o.y = pk2(s[2 * 33], s[3 * 33]); o.z = pk2(s[4 * 33], s[5 * 33]); o.w = pk2(s[6 * 33], s[7 * 33]);
        *(u32x4*)(WT + (size_t)maprow<MODE>(n0 + n, roff) * ldt + koff + k0 + 8 * c) = o; }
    asm volatile("s_waitcnt lgkmcnt(0)" ::: "memory");
}
__device__ __forceinline__ void convert_nonexpert(const Frame& F, const Args& a, int l, int gw, int NGW) {
    LAS float* scr = (LAS float*)(F.lds + F.wave * 16384);
    bf16_t* btin = (bf16_t*)(opq(F.ws) + O_BTIN + (size_t)(l & 1) * SZ_BTIN);
    bf16_t* btbr = (bf16_t*)(opq(F.ws) + O_BTBR + (size_t)(l & 1) * SZ_SQ);
    bf16_t* bto = (bf16_t*)(opq(F.ws) + O_BTO + (size_t)(l & 1) * SZ_SQ);
    const float* w_in = ldin(8) + (size_t)l * D * INW;
    const float* w_ba = ldin(12) + (size_t)l * 512 * D; const float* w_bs = ldin(13) + (size_t)l * 256 * D; const float* w_bf = ldin(14) + (size_t)l * 256 * D;
    const float* w_o = ldin(15) + (size_t)l * D * D;
    constexpr int I_IN = 16 * (INW / 32), I_BA = 8 * 32, I_BS = 4 * 32, I_BF = 4 * 32, I_O = 16 * 32;
    constexpr int NIT = I_IN + I_BA + I_BS + I_BF + I_O;
    for (int it = gw; it < NIT; it += NGW) {
        int r = it;
        if (r < I_IN) { xpose_item<1>(w_in, INW, btin, D, 0, 0, scr, r, F.lane, (unsigned char*)(opq(F.ws) + O_BTG8) + (size_t)(l & 1) * 3072 * D); continue; } r -= I_IN;
        if (r < I_BA) { xpose_item<0>(w_ba, D, btbr, D, 0, 0, scr, r, F.lane); continue; } r -= I_BA;
        if (r < I_BS) { xpose_item<0>(w_bs, D, btbr, D, 512, 0, scr, r, F.lane); continue; } r -= I_BS;
        if (r < I_BF) { xpose_item<0>(w_bf, D, btbr, D, 768, 0, scr, r, F.lane); continue; } r -= I_BF;
        xpose_item<0>(w_o, D, bto, D, 0, 0, scr, r, F.lane);
    }
}
__device__ __forceinline__ void fold_unit(const Frame& F, const Args& a, int l, int unit4) {
    const int unit = unit4 >> 2, qt = unit4 & 3; const int g = unit >> 4, kb = unit & 15;
    LAS float* wt = (LAS float*)(F.lds);
    LAS float* ct = wt + 64 * 65;
    const float* w_in = ldin(8) + (size_t)l * D * INW;
    bf16_t* btin = (bf16_t*)(opq(F.ws) + O_BTIN + (size_t)(l & 1) * SZ_BTIN);
    __syncthreads();
    for (int i = F.tid; i < 64 * 64; i += NTHR) { const int kk = i >> 6, d = i & 63; wt[kk * 65 + d] = w_in[(size_t)(kb * 64 + kk) * INW + 1280 + g * 64 + d]; }
    if (F.tid < 64) { float s, c; sincospif((float)F.tid * (1.0f / 32.0f), &s, &c); ct[F.tid] = c; ct[64 + F.tid] = s; }
    __syncthreads();
    const int kk = F.tid & 63, rg = F.tid >> 6;
#pragma unroll 1
    for (int rr = 4 * qt; rr < 4 * qt + 4; ++rr) { const int r = rg * 16 + rr, ri = r >> 6, m = r & 63; float s = 0.f;
        for (int d = 0; d < 64; ++d) { const int idx = (m * d) & 63; const float t = ri ? -ct[64 + idx] : ct[idx]; s += wt[kk * 65 + d] * t; }
        btin[(size_t)(1280 + ri * 256 + g * 64 + m) * D + kb * 64 + kk] = (bf16_t)f2bf(s * 0.125f); }
    __syncthreads();
}
__device__ __forceinline__ void convert_expert(const Frame& F, const Args& a, int l, int gw, int NGW, const int it_lo, const int it_hi) {
    LAS float* scr = (LAS float*)(F.lds + F.wave * 16896);
    unsigned char* btgu = (unsigned char*)(opq(F.ws) + O_BTGU); unsigned char* btd = (unsigned char*)(opq(F.ws) + O_BTD);
    const float* wgp = ldin(17) + (size_t)l * NE * D * FF; const float* wup = ldin(18) + (size_t)l * NE * D * FF; const float* wdp = ldin(19) + (size_t)l * NE * FF * D;
    constexpr int I_G = (D / 128) * (FF / 32), I_D = (FF / 128) * (D / 32), I_E = 2 * I_G + I_D, NTOT = NE * I_E;
    const int lr = F.lane >> 3, lc = (F.lane & 7) * 4;
#define XP_SRC(it, src, N, k0, n0) do { const int e_ = (it) / I_E; int r_ = (it) % I_E; \
        if (r_ < I_G) { src = wgp + (size_t)e_ * D * FF; N = FF; } else if (r_ < 2 * I_G) { src = wup + (size_t)e_ * D * FF; N = FF; r_ -= I_G; } else { src = wdp + (size_t)e_ * FF * D; N = D; r_ -= 2 * I_G; } \
        const int nblk_ = N / 32; k0 = 128 * (r_ / nblk_); n0 = 32 * (r_ % nblk_); } while (0)
#define XP_LOAD(dstR, itx) do { if ((itx) < it_hi) { const float* src_; int N_, k0_, n0_; XP_SRC((itx), src_, N_, k0_, n0_); \
            _Pragma("unroll") for (int i = 0; i < 16; ++i) dstR[i] = __builtin_nontemporal_load((const f32x4*)(src_ + (size_t)(k0_ + lr + 8 * i) * N_ + n0_ + lc)); } \
        else { _Pragma("unroll") for (int i = 0; i < 16; ++i) dstR[i] = (f32x4){0.f, 0.f, 0.f, 0.f}; } } while (0)
    int it = it_lo + gw; f32x4 R[16];
    XP_LOAD(R, it);
    while (it < it_hi) {
        const int itn = it + NGW; f32x4 Rn[16];
        XP_LOAD(Rn, itn);
#pragma unroll
        for (int i = 0; i < 16; ++i) { LAS float* p = scr + (lr + 8 * i) * 33 + lc; p[0] = R[i][0]; p[1] = R[i][1]; p[2] = R[i][2]; p[3] = R[i][3]; }
        asm volatile("s_waitcnt lgkmcnt(0)" ::: "memory");
        { const int e = it / I_E; int r = it % I_E; unsigned char* dst; int ldt, nblk, mode;
          if (r < I_G) { dst = btgu + (size_t)e * 4096 * D; ldt = D; nblk = FF / 32; mode = 2; } else if (r < 2 * I_G) { dst = btgu + (size_t)e * 4096 * D; ldt = D; nblk = FF / 32; mode = 3; r -= I_G; } else { dst = btd + (size_t)e * D * FF; ldt = FF; nblk = D / 32; mode = 0; r -= 2 * I_G; }
          const int k0 = 128 * (r / nblk), n0 = 32 * (r % nblk); const int c = F.lane & 7;
#pragma unroll
          for (int j = 0; j < 4; ++j) { const int n = (F.lane >> 3) + 8 * j; const LAS float* sp = scr + (16 * c) * 33 + n;
              u32x4 o;
#pragma unroll
              for (int q = 0; q < 4; ++q) o[q] = pk4_fp8(sp[(4 * q) * 33] * 32.0f, sp[(4 * q + 1) * 33] * 32.0f, sp[(4 * q + 2) * 33] * 32.0f, sp[(4 * q + 3) * 33] * 32.0f);
              const int nn = n0 + n; const int drow = mode == 0 ? nn : (nn >> 7) * 256 + (mode == 3 ? 128 : 0) + (nn & 127);
              *(u32x4*)(dst + (size_t)drow * ldt + k0 + 16 * c) = o; } }
        asm volatile("s_waitcnt lgkmcnt(0)" ::: "memory");
#pragma unroll
        for (int i = 0; i < 16; ++i) R[i] = Rn[i];
        it = itn;
    }
#undef XP_LOAD
#undef XP_SRC
}

__device__ __forceinline__ void convert_expert_blk(const Frame& F, int l, int wg, int NWG, const int it_lo, const int it_hi) {
    LAS unsigned* T = (LAS unsigned*)(F.lds);
    unsigned char* btgu = (unsigned char*)(opq(F.ws) + O_BTGU); unsigned char* btd = (unsigned char*)(opq(F.ws) + O_BTD);
    const float* wgp = ldin(17) + (size_t)l * NE * D * FF; const float* wup = ldin(18) + (size_t)l * NE * D * FF; const float* wdp = ldin(19) + (size_t)l * NE * FF * D;
    const int ncol4 = (F.tid & 127) * 4, kgrp = F.tid >> 7;
    for (int it = it_lo + wg; it < it_hi; it += NWG) {
        const int e = it / 96; int r = it % 96; const float* src; unsigned char* dst; int N, ldt, mode;
        if (r < 32) { src = wgp + (size_t)e * D * FF; dst = btgu + (size_t)e * 4096 * D; N = FF; ldt = D; mode = 2; }
        else if (r < 64) { src = wup + (size_t)e * D * FF; dst = btgu + (size_t)e * 4096 * D; N = FF; ldt = D; mode = 3; r -= 32; }
        else { src = wdp + (size_t)e * FF * D; dst = btd + (size_t)e * D * FF; N = D; ldt = FF; mode = 0; r -= 64; }
        const int nblk = N / 512, kb = r / nblk, nb = r % nblk;
        const float* sp = src + (size_t)(kb * 128 + kgrp * 32) * N + nb * 512 + ncol4;
        f32x4 v[32];
#pragma unroll
        for (int i = 0; i < 32; ++i) v[i] = __builtin_nontemporal_load((const f32x4*)(sp + (size_t)i * N));
#pragma unroll
        for (int q = 0; q < 8; ++q) { LAS unsigned* tp = T + (kgrp * 8 + q) * 513 + ncol4;
#pragma unroll
            for (int i = 0; i < 4; ++i) tp[i] = pk4_fp8(v[4 * q][i] * 32.0f, v[4 * q + 1][i] * 32.0f, v[4 * q + 2][i] * 32.0f, v[4 * q + 3][i] * 32.0f); }
        __syncthreads();
        { const int c = F.tid & 7;
#pragma unroll
          for (int j = 0; j < 8; ++j) { const int n = (F.tid >> 3) + 64 * j; const LAS unsigned* tq = T + (4 * c) * 513 + n;
              const u32x4 o = {tq[0], tq[513], tq[2 * 513], tq[3 * 513]};
              const int nn = nb * 512 + n; const int drow = mode == 0 ? nn : (nn >> 7) * 256 + (mode == 3 ? 128 : 0) + (nn & 127);
              *(u32x4*)(dst + (size_t)drow * ldt + kb * 128 + 16 * c) = o; } }
        __syncthreads();
    }
}

constexpr int XI_PER_EXPERT = 384, XI_PER_LAYER = NE * XI_PER_EXPERT;
constexpr size_t SZ_GU8 = (size_t)NE * 4096 * D, SZ_D8 = (size_t)NE * D * FF;
__device__ __forceinline__ void convert_item128(const Frame& F, const int L, const int id) {
    LAS unsigned* T = (LAS unsigned*)(F.lds);
    unsigned char* btgu = (unsigned char*)(opq(F.ws) + O_BTGU) + (size_t)(L & 1) * SZ_GU8; unsigned char* btd = (unsigned char*)(opq(F.ws) + O_BTD) + (size_t)(L & 1) * SZ_D8;
    const float* wgp = ldin(17) + (size_t)L * NE * D * FF; const float* wup = ldin(18) + (size_t)L * NE * D * FF; const float* wdp = ldin(19) + (size_t)L * NE * FF * D;
    const int ncol4 = (F.tid & 31) * 4, kgrp = F.tid >> 5;
    const int e = id / XI_PER_EXPERT; int r = id % XI_PER_EXPERT; const float* src; unsigned char* dst; int N, ldt, mode;
    if (r < 128) { src = wgp + (size_t)e * D * FF; dst = btgu + (size_t)e * 4096 * D; N = FF; ldt = D; mode = 2; }
    else if (r < 256) { src = wup + (size_t)e * D * FF; dst = btgu + (size_t)e * 4096 * D; N = FF; ldt = D; mode = 3; r -= 128; }
    else { src = wdp + (size_t)e * FF * D; dst = btd + (size_t)e * D * FF; N = D; ldt = FF; mode = 0; r -= 256; }
    const int nblk = N / 128, kb = r / nblk, nb = r % nblk;
    const float* sp = src + (size_t)(kb * 128 + kgrp * 8) * N + nb * 128 + ncol4;
    f32x4 v[8];
#pragma unroll
    for (int i = 0; i < 8; ++i) v[i] = __builtin_nontemporal_load((const f32x4*)(sp + (size_t)i * N));
#pragma unroll
    for (int q = 0; q < 2; ++q) { LAS unsigned* tp = T + (kgrp * 2 + q) * 129 + ncol4;
#pragma unroll
        for (int i = 0; i < 4; ++i) tp[i] = pk4_fp8(v[4 * q][i] * 32.0f, v[4 * q + 1][i] * 32.0f, v[4 * q + 2][i] * 32.0f, v[4 * q + 3][i] * 32.0f); }
    __syncthreads();
    { const int c = F.tid & 7;
#pragma unroll
      for (int j = 0; j < 2; ++j) { const int n = (F.tid >> 3) + 64 * j; const LAS unsigned* tq = T + (4 * c) * 129 + n;
          const u32x4 o = {tq[0], tq[129], tq[2 * 129], tq[3 * 129]};
          const int nn = nb * 128 + n; const int drow = mode == 0 ? nn : nb * 256 + (mode == 3 ? 128 : 0) + n;
          *(u32x4*)(dst + (size_t)drow * ldt + kb * 128 + 16 * c) = o; } }
    __syncthreads();
}
constexpr int CW_XI = 12288;
__device__ __forceinline__ bool fill_one(const Frame& F, unsigned* ctl, volatile LAS unsigned* fw, const int maxL) {
    if (F.wave == 0 && lane_id() == 0) { int L = (int)fw[6], id = -1;
        while (L <= maxL && L < DEPTH) { const unsigned c = xb_add(ctl + CW_XI + 64 * L, 1u); if (c < (unsigned)XI_PER_LAYER) { id = (int)c; break; } ++L; }
        fw[6] = (unsigned)L; fw[4] = (unsigned)id; fw[5] = (unsigned)L; }
    __syncthreads();
    const int id = (int)fw[4], L = (int)fw[5];
    __syncthreads();
    if (id < 0) return false;
    convert_item128(F, L, id);
    return true;
}

__device__ __forceinline__ void xcd_barrier_fill(const XcdBarrier& b, const Frame& F, unsigned* ctl, volatile LAS unsigned* fw, const int maxL) {
    asm volatile("s_waitcnt vmcnt(0)" ::: "memory");
    __syncthreads();
    const bool t0 = (F.wave == 0) && (lane_id() == 0);
    if (t0) {
        unsigned* bar = b.bar;
        __builtin_amdgcn_s_waitcnt(0);
        unsigned nloc = b.st[0], nx = b.st[1];
        if (nloc == 0u) { xcd_barrier_complete(bar, b.x, nloc, nx); b.st[0] = nloc; b.st[1] = nx; }
        const unsigned old = xb_add(&bar[XB_XSUB(b.x)], 1u);
        const unsigned gen = old / nloc;
        if (old + 1u == (gen + 1u) * nloc) {
            __builtin_amdgcn_fence(__ATOMIC_RELEASE, "agent");
            asm volatile("s_waitcnt vmcnt(0)" ::: "memory");
            const unsigned og = xb_add(&bar[XB_TOP], 1u);
            const unsigned tg = og / nx;
            if (og + 1u == (tg + 1u) * nx) xb_add(&bar[XB_TOPGEN], 1u);
            else XB_SPIN(xb_ld(&bar[XB_TOPGEN]) == tg, bar);
            __builtin_amdgcn_fence(__ATOMIC_ACQUIRE, "agent");
            xb_add(&bar[XB_XGEN(b.x)], 1u);
            asm volatile("s_waitcnt vmcnt(0)" ::: "memory");
            fw[0] = 2u;
        } else { fw[1] = gen; fw[0] = (xb_ld(&bar[XB_XGEN(b.x)]) != gen) ? 1u : 0u; }
    }
    __syncthreads();
    unsigned polls = 0;
    while (fw[0] == 0u) {
        const bool did = fill_one(F, ctl, fw, maxL);
        if (!did) __builtin_amdgcn_s_sleep(16);
        if (t0) { unsigned* bar = b.bar; const unsigned gen = fw[1]; unsigned r = (xb_ld(&bar[XB_XGEN(b.x)]) != gen) ? 1u : 0u;
            if (!r) { if (xb_ld(&bar[XB_TMO])) r = 1u; else if (++polls > XB_SPIN_CAP) { atomicAdd(&bar[XB_TMO], 1u); r = 1u; } }
            fw[0] = r; }
        __syncthreads();
    }
    if (t0 && fw[0] == 1u) { __builtin_amdgcn_fence(__ATOMIC_ACQUIRE, "agent"); asm volatile("s_waitcnt vmcnt(0)" ::: "memory"); }
    __syncthreads();
}

__device__ __forceinline__ void modvec_units(const Frame& F, const Args& a) {
    LAS float* sv = (LAS float*)(F.lds);
    LAS float* part = sv + 3 * 1024;
    __syncthreads();
    for (int i = F.tid; i < 3 * 1024; i += NTHR) { const float x = i < 2048 ? ldin(1)[i] : ldin(3)[i - 2048]; sv[i] = x / (1.0f + __expf(-x)); }
    __syncthreads();
    float* modv = (float*)(opq(F.ws) + O_MODV);
    const int c4 = (F.tid & 7) * 4, kg = F.tid >> 3;
    for (int unit = F.blk; unit < DEPTH * 192; unit += F.G) {
        const int l = unit / 192, cb = unit % 192;
        const float* w = ldin(4) + (size_t)l * D * NMOD + (size_t)(kg * 16) * NMOD + cb * 32 + c4;
        f32x4 wv[16];
#pragma unroll
        for (int i = 0; i < 16; ++i) wv[i] = *(const f32x4*)(w + (size_t)i * NMOD);
        f32x4 s0 = {0.f, 0.f, 0.f, 0.f}, s1 = s0, s2 = s0;
#pragma unroll
        for (int i = 0; i < 16; ++i) { const int k = kg * 16 + i; s0 += wv[i] * sv[k]; s1 += wv[i] * sv[1024 + k]; s2 += wv[i] * sv[2048 + k]; }
        *(LAS f32x4*)(part + (kg * 3 + 0) * 32 + c4) = s0; *(LAS f32x4*)(part + (kg * 3 + 1) * 32 + c4) = s1; *(LAS f32x4*)(part + (kg * 3 + 2) * 32 + c4) = s2;
        __syncthreads();
        if (F.tid < 96) { const int v = F.tid >> 5, jj = F.tid & 31; float s = ldin(5)[(size_t)l * NMOD + cb * 32 + jj];
#pragma unroll 8
            for (int q = 0; q < 64; ++q) s += part[(q * 3 + v) * 32 + jj];
            modv[((size_t)l * 3 + v) * NMOD + cb * 32 + jj] = s; }
        __syncthreads();
    }
}
__device__ __forceinline__ void tables(const Frame& F) {
    const size_t gt = (size_t)F.blk * NTHR + F.tid, GT = (size_t)F.G * NTHR;
    float* rc = (float*)(opq(F.ws) + O_ROPEC); float* rs = (float*)(opq(F.ws) + O_ROPES);
    for (size_t i = gt; i < (size_t)SEQ * 32; i += GT) { const int n = (int)(i >> 5), p = (int)(i & 31); const int row = n >> 6, col = n & 63;
        const float inv = powf(10000.0f, -(float)(p & 15) * (1.0f / 16.0f)); const float ang = (float)(p < 16 ? row : col) * inv;
        rc[i] = cosf(ang); rs[i] = sinf(ang); }
    float* twc = (float*)(opq(F.ws) + O_TWC); float* tws = (float*)(opq(F.ws) + O_TWS);
    for (size_t i = gt; i < 128 * 128; i += GT) { const int k1 = (int)(i >> 7), n2 = (int)(i & 127); float s, c; sincospif((float)((k1 * n2) & 16383) * (1.0f / 8192.0f), &s, &c); twc[i] = c; tws[i] = s; }
    bf16_t* TA = (bf16_t*)(opq(F.ws) + O_TA); bf16_t* TC = (bf16_t*)(opq(F.ws) + O_TC); bf16_t* TX = (bf16_t*)(opq(F.ws) + O_TX);
    const float sc = 0.08838834764831845f;
    for (size_t i = gt; i < 256 * 256; i += GT) { const int r = (int)(i >> 8), k = (int)(i & 255); const int ri = r >> 7, k1 = r & 127, rip = k >> 7, n1 = k & 127;
        float s, c; sincospif((float)((k1 * n1) & 127) * (1.0f / 64.0f), &s, &c);
        const float v = (ri == rip) ? c : (ri == 0 ? s : -s);
        TA[i] = (bf16_t)f2bf(v * sc);
        TC[i] = (bf16_t)f2bf((rip == 0 ? c : s) * sc); }
    for (size_t i = gt; i < 256 * 512; i += GT) { const int k = (int)(i >> 9), kk = (int)(i & 511); const int rip = kk >> 8, n = kk & 255;
        float s, c; sincospif((float)((k * n) & 255) * (1.0f / 128.0f), &s, &c); TX[i] = (bf16_t)f2bf((rip == 0 ? c : s) * 0.0625f); }
}

__device__ __forceinline__ void norm_mod_store(const f32x4 (&v)[4], const float* gain, const float* sh, const float* sc, bf16_t* orow, unsigned char* orow8, int lane) {
    float ss = 0.f;
#pragma unroll
    for (int j = 0; j < 4; ++j) ss += (v[j][0] * v[j][0] + v[j][1] * v[j][1]) + (v[j][2] * v[j][2] + v[j][3] * v[j][3]);
    const float r = __builtin_amdgcn_rsqf(wave_sum(ss) * (1.0f / D) + EPS);
#pragma unroll
    for (int j = 0; j < 4; ++j) { const f32x4 g = ((const f32x4*)gain)[lane + 64 * j], s1 = ((const f32x4*)sc)[lane + 64 * j], s0 = ((const f32x4*)sh)[lane + 64 * j];
        const f32x4 y = v[j] * r * g * (s1 + 1.0f) + s0;
        ((u32x2*)orow)[lane + 64 * j] = (u32x2){pk2(y[0], y[1]), pk2(y[2], y[3])};
        ((unsigned*)orow8)[lane + 64 * j] = pk4_fp8(y[0], y[1], y[2], y[3]); }
}
__device__ __forceinline__ int modsel(int row) { return row < SEQ ? 0 : row < NLAT ? 1 : 2; }
__device__ __forceinline__ void phase_norm1_in(const Frame& F, const Args& a) {
    const int gw = F.blk * NWAVES + F.wave, NGW = F.G * NWAVES;
    const float* modv = (const float*)(opq(F.ws) + O_MODV); bf16_t* HB = (bf16_t*)(opq(F.ws) + O_HB);
    const float* xlat = ldin(0); const float* xctx = ldin(2) - (size_t)NLAT * D;
    f32x4 vn[4];
    if (gw < NR) { const float* xr = (gw < NLAT ? xlat : xctx) + (size_t)gw * D;
#pragma unroll
        for (int j = 0; j < 4; ++j) vn[j] = ((const f32x4*)xr)[F.lane + 64 * j]; }
    for (int row = gw; row < NR; row += NGW) {
        f32x4 v[4];
#pragma unroll
        for (int j = 0; j < 4; ++j) v[j] = vn[j];
        if (row + NGW < NR) { const int rn = row + NGW; const float* xr = (rn < NLAT ? xlat : xctx) + (size_t)rn * D;
#pragma unroll
            for (int j = 0; j < 4; ++j) vn[j] = ((const f32x4*)xr)[F.lane + 64 * j]; }
        const float* mv = modv + (size_t)modsel(row) * NMOD;
        norm_mod_store(v, ldin(6), mv, mv + D, HB + (size_t)row * D, (unsigned char*)(opq(F.ws) + O_HB8) + (size_t)row * D, F.lane);
    }
}
__device__ __forceinline__ void phase_norm2(const Frame& F, const Args& a, int l, const int rowlo, const int rowhi, const int gw, const int NGW) {
    LAS float* wr = (LAS float*)(F.lds);
    __syncthreads();
    { const float* w = ldin(16) + (size_t)l * D * NE; for (int i = F.tid; i < D * NE / 4; i += NTHR) { const f32x4 w4 = ((const f32x4*)w)[i]; const int k = i >> 2, e0 = (i & 3) * 4;
        wr[(e0 + 0) * D + k] = w4[0]; wr[(e0 + 1) * D + k] = w4[1]; wr[(e0 + 2) * D + k] = w4[2]; wr[(e0 + 3) * D + k] = w4[3]; } }
    __syncthreads();
    const float* modv = (const float*)(opq(F.ws) + O_MODV) + (size_t)l * 3 * NMOD; const float* gain = ldin(7) + (size_t)l * D;
    const float* XW = (const float*)(opq(F.ws) + O_XW); unsigned char* HB8 = (unsigned char*)(opq(F.ws) + O_HB8);
    float* affl = (float*)(opq(F.ws) + O_AFFL); float* affc = (float*)(opq(F.ws) + O_AFFC);
    const bf16_t* XWb = (const bf16_t*)(opq(F.ws) + O_XW);
    u32x2 vn[4];
    { const int row0 = rowlo + gw; if (row0 < rowhi) {
#pragma unroll
        for (int j = 0; j < 4; ++j) vn[j] = ((const u32x2*)(XWb + (size_t)row0 * D))[F.lane + 64 * j]; } }
    for (int row = rowlo + gw; row < rowhi; row += NGW) {
        const float* mv = modv + (size_t)modsel(row) * NMOD;
        f32x4 v[4]; float ss = 0.f;
#pragma unroll
        for (int j = 0; j < 4; ++j) { v[j] = (f32x4){bflo(vn[j][0]), bfhi(vn[j][0]), bflo(vn[j][1]), bfhi(vn[j][1])}; ss += (v[j][0] * v[j][0] + v[j][1] * v[j][1]) + (v[j][2] * v[j][2] + v[j][3] * v[j][3]); }
        if (row + NGW < rowhi) {
#pragma unroll
            for (int j = 0; j < 4; ++j) vn[j] = ((const u32x2*)(XWb + (size_t)(row + NGW) * D))[F.lane + 64 * j]; }
        const float r = __builtin_amdgcn_rsqf(wave_sum(ss) * (1.0f / D) + EPS);
        float lg[16];
#pragma unroll
        for (int e = 0; e < 16; ++e) lg[e] = 0.f;
#pragma unroll
        for (int j = 0; j < 4; ++j) { __builtin_amdgcn_sched_barrier(0);
            const f32x4 g = ((const f32x4*)gain)[F.lane + 64 * j], s1 = ((const f32x4*)(mv + 4 * D))[F.lane + 64 * j], s0 = ((const f32x4*)(mv + 3 * D))[F.lane + 64 * j];
            const f32x4 h = v[j] * r * g * (s1 + 1.0f) + s0;
            ((unsigned*)(HB8 + (size_t)row * D))[F.lane + 64 * j] = pk4_fp8(h[0], h[1], h[2], h[3]);
#pragma unroll
            for (int e = 0; e < 16; ++e) { if ((e & 7) == 0) __builtin_amdgcn_sched_barrier(0);
                const f32x4 w4 = ((const LAS f32x4*)(wr + e * D))[F.lane + 64 * j]; lg[e] += (h[0] * w4[0] + h[1] * w4[1]) + (h[2] * w4[2] + h[3] * w4[3]); } }
        const bool b5 = (F.lane & 32) != 0, b4 = (F.lane & 16) != 0, b3 = (F.lane & 8) != 0, b2 = (F.lane & 4) != 0;
        float a8[8], a4[4], a2[2], a1;
#pragma unroll
        for (int i = 0; i < 8; ++i) { const float keep = b5 ? lg[i + 8] : lg[i], send = b5 ? lg[i] : lg[i + 8]; a8[i] = keep + __shfl_xor(send, 32); }
#pragma unroll
        for (int i = 0; i < 4; ++i) { const float keep = b4 ? a8[i + 4] : a8[i], send = b4 ? a8[i] : a8[i + 4]; a4[i] = keep + __shfl_xor(send, 16); }
#pragma unroll
        for (int i = 0; i < 2; ++i) { const float keep = b3 ? a4[i + 2] : a4[i], send = b3 ? a4[i] : a4[i + 2]; a2[i] = keep + __shfl_xor(send, 8); }
        { const float keep = b2 ? a2[1] : a2[0], send = b2 ? a2[0] : a2[1]; a1 = keep + __shfl_xor(send, 4); }
        a1 += __shfl_xor(a1, 2); a1 += __shfl_xor(a1, 1);
        float mx = a1;
        mx = fmaxf(mx, __shfl_xor(mx, 32)); mx = fmaxf(mx, __shfl_xor(mx, 16)); mx = fmaxf(mx, __shfl_xor(mx, 8)); mx = fmaxf(mx, __shfl_xor(mx, 4));
        const float ex = __expf(a1 - mx);
        float den = ex; den += __shfl_xor(den, 32); den += __shfl_xor(den, 16); den += __shfl_xor(den, 8); den += __shfl_xor(den, 4);
        const float mine = ex / den; const int e = (F.lane >> 2) & 15;
        if ((F.lane & 3) == 0) { if (row < NLAT) affl[((size_t)(row >> 14) * NE + e) * SEQ + (row & (SEQ - 1))] = mine;
                                 else { const int rc = row - NLAT; affc[((size_t)(rc >> 8) * NE + e) * LCTX + (rc & 255)] = mine; } }
    }
}
__device__ __forceinline__ void phase_combine(const Frame& F, const Args& a, int l) {
    const int gw = F.blk * NWAVES + F.wave, NGW = F.G * NWAVES;
    const float* modv = (const float*)(opq(F.ws) + O_MODV) + (size_t)l * 3 * NMOD;
    float* XW = (float*)(opq(F.ws) + O_XW); bf16_t* HB = (bf16_t*)(opq(F.ws) + O_HB);
    const int* slotof = (const int*)(opq(F.ws) + O_SLOTOF); const float* gsel = (const float*)(opq(F.ws) + O_GSEL); const bf16_t* YB = (const bf16_t*)(opq(F.ws) + O_YB);
    const bool last = (l == DEPTH - 1);
    const int rr = F.lane >> 4, li = F.lane & 15;
    const int ngrp = (last ? NLAT : NR) / 4;
    for (int gi = gw; gi < ngrp; gi += NGW) {
        const int row = gi * 4 + rr;
        const float* mv = modv + (size_t)modsel(gi * 4) * NMOD;
        bf16_t* xr = (bf16_t*)XW + (size_t)row * D;
        int myslot = slotof[(size_t)li * NR + row]; float myg = 0.f; if (myslot >= 0) myg = gsel[li * EROWS + myslot];
        f32x4 v[16], accv[16];
#pragma unroll
        for (int j = 0; j < 8; ++j) { const u32x4 xw = *(const u32x4*)(xr + 8 * (li + 16 * j)); v[2 * j] = (f32x4){bflo(xw[0]), bfhi(xw[0]), bflo(xw[1]), bfhi(xw[1])}; v[2 * j + 1] = (f32x4){bflo(xw[2]), bfhi(xw[2]), bflo(xw[3]), bfhi(xw[3])}; accv[2 * j] = (f32x4){0.f, 0.f, 0.f, 0.f}; accv[2 * j + 1] = (f32x4){0.f, 0.f, 0.f, 0.f}; }
        const unsigned long long bal = __ballot(myslot >= 0);
        unsigned m16 = (unsigned)(bal >> (16 * rr)) & 0xffffu;
        int nmax = __builtin_popcount((unsigned)(bal & 0xffffull)); { const int n1 = __builtin_popcount((unsigned)((bal >> 16) & 0xffffull)), n2 = __builtin_popcount((unsigned)((bal >> 32) & 0xffffull)), n3 = __builtin_popcount((unsigned)((bal >> 48) & 0xffffull));
            nmax = nmax > n1 ? nmax : n1; nmax = nmax > n2 ? nmax : n2; nmax = nmax > n3 ? nmax : n3; }
#define CB_FETCH(W, G, A) do { A = m16 != 0u; const int e_ = A ? (__builtin_ffs((int)m16) - 1) : 0; m16 &= m16 - 1u; \
            const int s_ = __shfl(myslot, 16 * rr + e_); const float gv_ = __shfl(myg, 16 * rr + e_); G = gv_ * 0.125f; \
            if (A) { const u32x2* yr_ = (const u32x2*)((const unsigned char*)YB + ((size_t)e_ * EROWS + s_) * D);        \
                _Pragma("unroll") for (int j = 0; j < 8; ++j) W[j] = yr_[li + 16 * j]; } } while (0)
        u32x2 wc_[8]; float gcur = 0.f; bool acur = false;
        if (nmax > 0) CB_FETCH(wc_, gcur, acur);
#pragma unroll 1
        for (int i = 0; i < nmax; ++i) {
            u32x2 wn_[8]; float gnx = 0.f; bool anx = false;
#pragma unroll
            for (int j = 0; j < 8; ++j) wn_[j] = (u32x2){0u, 0u};
            if (i + 1 < nmax) CB_FETCH(wn_, gnx, anx);
            if (acur) {
#pragma unroll
                for (int j = 0; j < 8; ++j) { const f32x2 a0 = __builtin_amdgcn_cvt_pk_f32_fp8((int)wc_[j][0], false), a1 = __builtin_amdgcn_cvt_pk_f32_fp8((int)wc_[j][0], true), b0 = __builtin_amdgcn_cvt_pk_f32_fp8((int)wc_[j][1], false), b1 = __builtin_amdgcn_cvt_pk_f32_fp8((int)wc_[j][1], true);
                    accv[2 * j] += (f32x4){a0[0], a0[1], a1[0], a1[1]} * gcur; accv[2 * j + 1] += (f32x4){b0[0], b0[1], b1[0], b1[1]} * gcur; } }
#pragma unroll
            for (int j = 0; j < 8; ++j) wc_[j] = wn_[j];
            gcur = gnx; acur = anx;
        }
#undef CB_FETCH
        float ss = 0.f;
#pragma unroll
        for (int j = 0; j < 8; ++j) {
#pragma unroll
            for (int h = 0; h < 2; ++h) { const f32x4 gt = *(const f32x4*)(mv + 5 * D + 8 * (li + 16 * j) + 4 * h); f32x4& x = v[2 * j + h]; x += gt * accv[2 * j + h];
                ss += (x[0] * x[0] + x[1] * x[1]) + (x[2] * x[2] + x[3] * x[3]); } }
        ss += __shfl_xor(ss, 1); ss += __shfl_xor(ss, 2); ss += __shfl_xor(ss, 4); ss += __shfl_xor(ss, 8);
        const float r = __builtin_amdgcn_rsqf(ss * (1.0f / D) + EPS);
        if (!last) {
            const float* mvn = mv + (size_t)3 * NMOD;
            const float* gain = ldin(6) + (size_t)(l + 1) * D; bf16_t* orow = HB + (size_t)row * D; unsigned char* orow8 = (unsigned char*)(opq(F.ws) + O_HB8) + (size_t)row * D;
#pragma unroll
            for (int j = 0; j < 8; ++j) { const int c0 = 8 * (li + 16 * j);
                *(u32x4*)(xr + c0) = pack8(v[2 * j], v[2 * j + 1]);
                f32x4 y[2];
#pragma unroll
                for (int h = 0; h < 2; ++h) { const f32x4 g = *(const f32x4*)(gain + c0 + 4 * h), s1 = *(const f32x4*)(mvn + D + c0 + 4 * h), s0 = *(const f32x4*)(mvn + c0 + 4 * h); y[h] = v[2 * j + h] * r * g * (s1 + 1.0f) + s0; }
                *(u32x4*)(orow + c0) = pack8(y[0], y[1]);
                *(u32x2*)(orow8 + c0) = (u32x2){pk4_fp8(y[0][0], y[0][1], y[0][2], y[0][3]), pk4_fp8(y[1][0], y[1][1], y[1][2], y[1][3])}; }
        } else {
            const float* gf = ldin(20); float* orow = ldout() + (size_t)row * D;
#pragma unroll
            for (int j = 0; j < 8; ++j) { const int c0 = 8 * (li + 16 * j);
                *(f32x4*)(orow + c0) = v[2 * j] * r * *(const f32x4*)(gf + c0); *(f32x4*)(orow + c0 + 4) = v[2 * j + 1] * r * *(const f32x4*)(gf + c0 + 4); }
        }
    }
}
__device__ __forceinline__ void phase_gather(const Frame& F, const bool latonly) {
    const int gw = F.blk * NWAVES + F.wave, NGW = F.G * NWAVES;
    const int* rowsel = (const int*)(opq(F.ws) + O_ROWSEL); const unsigned char* HB8 = (const unsigned char*)(opq(F.ws) + O_HB8); unsigned char* XE = (unsigned char*)(opq(F.ws) + O_XE);
    for (int er0 = gw; er0 < NEROWS; er0 += 4 * NGW) { int src[4]; bool ok[4]; u32x4 v[4];
#pragma unroll
        for (int q = 0; q < 4; ++q) { const int er = er0 + q * NGW; ok[q] = er < NEROWS && !(latonly && (er % EROWS) >= 2 * CAP); src[q] = ok[q] ? rowsel[er] : 0; }
#pragma unroll
        for (int q = 0; q < 4; ++q) v[q] = ((const u32x4*)(HB8 + (size_t)src[q] * D))[F.lane];
#pragma unroll
        for (int q = 0; q < 4; ++q) if (ok[q]) ((u32x4*)(XE + (size_t)(er0 + q * NGW) * D))[F.lane] = v[q]; }
}

__device__ __forceinline__ unsigned block_excl_scan(unsigned v, LAS unsigned* wsum, int tid, int lane, int wave, unsigned& total) {
    unsigned inc = v;
#pragma unroll
    for (int o = 1; o < 64; o <<= 1) { const unsigned t = __shfl_up(inc, o); if (lane >= o) inc += t; }
    __syncthreads();
    if (lane == 63) wsum[wave] = inc;
    __syncthreads();
    unsigned base = 0, tot = 0;
#pragma unroll
    for (int w = 0; w < NWAVES; ++w) { const unsigned s = wsum[w]; if (w < wave) base += s; tot += s; }
    total = tot;
    return base + inc - v;
}
__device__ __forceinline__ void select_unit(const Frame& F, int unit) {
    LAS unsigned* hist = (LAS unsigned*)(F.lds);
    LAS unsigned* sh = hist + 256;
    LAS unsigned* wsum = sh + 8;
    LAS int* srow = (LAS int*)(wsum + 8);
    const bool isctx = unit >= 32; const int ub = isctx ? unit - 32 : unit; const int b = ub >> 4, e = ub & 15;
    const int n = isctx ? LCTX : SEQ, k = isctx ? CAPC : CAP;
    const float* src = isctx ? (const float*)(opq(F.ws) + O_AFFC) + (size_t)(b * NE + e) * LCTX : (const float*)(opq(F.ws) + O_AFFL) + (size_t)(b * NE + e) * SEQ;
    const int rowbase = isctx ? NLAT + b * LCTX : b * SEQ, slotbase = isctx ? 2 * CAP + b * CAPC : b * CAP;
    int* rowsel = (int*)(opq(F.ws) + O_ROWSEL) + e * EROWS; float* gsel = (float*)(opq(F.ws) + O_GSEL) + e * EROWS; int* slotof = (int*)(opq(F.ws) + O_SLOTOF) + (size_t)e * NR;
    const bool act = F.tid * 32 < n;
    unsigned key[32];
#pragma unroll
    for (int q = 0; q < 8; ++q) { u32x4 w = {0u, 0u, 0u, 0u}; if (act) w = ((const u32x4*)(src + F.tid * 32))[q]; key[4 * q] = w[0]; key[4 * q + 1] = w[1]; key[4 * q + 2] = w[2]; key[4 * q + 3] = w[3]; }
    unsigned prefix = 0, kk = (unsigned)k;
#pragma unroll 1
    for (int pass = 3; pass >= 0; --pass) {
        const int shift = 8 * pass;
        __syncthreads();
        if (F.tid < 256) hist[F.tid] = 0u;
        __syncthreads();
        if (act) {
#pragma unroll
            for (int i = 0; i < 32; ++i) { const bool m = (pass == 3) ? true : ((key[i] >> (shift + 8)) == prefix); if (m) __hip_atomic_fetch_add(&hist[(key[i] >> shift) & 255u], 1u, __ATOMIC_RELAXED, __HIP_MEMORY_SCOPE_WORKGROUP); }
        }
        __syncthreads();
        if (F.wave == 0) {
            const unsigned h0 = hist[4 * F.lane], h1 = hist[4 * F.lane + 1], h2 = hist[4 * F.lane + 2], h3 = hist[4 * F.lane + 3];
            const unsigned s = h0 + h1 + h2 + h3; unsigned suf = s;
#pragma unroll
            for (int o = 1; o < 64; o <<= 1) { const unsigned t = __shfl_down(suf, o); if (F.lane + o < 64) suf += t; }
            const unsigned above = suf - s;
            if (above < kk && kk <= suf) { unsigned c = above; int d;
                if (c + h3 >= kk) d = 3; else { c += h3; if (c + h2 >= kk) d = 2; else { c += h2; if (c + h1 >= kk) d = 1; else { c += h1; d = 0; } } }
                sh[0] = (prefix << 8) | (unsigned)(4 * F.lane + d); sh[1] = kk - c; }
        }
        __syncthreads();
        prefix = sh[0]; kk = sh[1];
    }
    const unsigned T = prefix;
    unsigned ceq = 0;
#pragma unroll
    for (int i = 0; i < 32; ++i) ceq += (act && key[i] == T) ? 1u : 0u;
    unsigned tot;
    unsigned eqb = block_excl_scan(ceq, wsum, F.tid, F.lane, F.wave, tot);
    unsigned selmask = 0, csel = 0;
#pragma unroll
    for (int i = 0; i < 32; ++i) { bool s = false; if (act) { if (key[i] > T) s = true; else if (key[i] == T) { s = eqb < kk; ++eqb; } } if (s) { selmask |= 1u << i; ++csel; } }
    unsigned slot = block_excl_scan(csel, wsum, F.tid, F.lane, F.wave, tot);
    if (act) {
#pragma unroll
        for (int i = 0; i < 32; ++i) { const int row = rowbase + F.tid * 32 + i;
            if (selmask & (1u << i)) { const int sl = slotbase + (int)slot; if (isctx) srow[slot] = row; ++slot; slotof[row] = sl; rowsel[sl] = row; gsel[sl] = __builtin_bit_cast(float, key[i]); }
            else slotof[row] = -1; }
    }
    if (isctx && b == 1 && F.tid < EROWS - (2 * CAP + 2 * CAPC)) { rowsel[2 * CAP + 2 * CAPC + F.tid] = 0; gsel[2 * CAP + 2 * CAPC + F.tid] = 0.f; }
    __syncthreads();
    if (isctx) {
        const unsigned char* HB8 = (const unsigned char*)(opq(F.ws) + O_HB8); unsigned char* XE = (unsigned char*)(opq(F.ws) + O_XE);
        for (int si = F.wave; si < CAPC; si += NWAVES) { const int src = srow[si];
            ((u32x4*)(XE + ((size_t)e * EROWS + slotbase + si) * D))[F.lane] = ((const u32x4*)(HB8 + (size_t)src * D))[F.lane]; }
        __syncthreads();
    }
}

__device__ __forceinline__ int crow(int r, int hi) { return (r & 3) + 8 * (r >> 2) + 4 * hi; }
__device__ __forceinline__ void attn_unit(const Frame& F, int unit, const float* sinkv  ) {
    constexpr int KP = 144;
    constexpr int BUFB = 2 * 64 * KP;
    const bf16_t* QB = (const bf16_t*)(opq(F.ws) + O_QB); const bf16_t* KVB = (const bf16_t*)(opq(F.ws) + O_KVB); bf16_t* CAT = (bf16_t*)(opq(F.ws) + O_CAT);
    const bool isctx = unit >= 512; int b, qb, kvh;
    if (!isctx) { b = unit >> 8; qb = (unit >> 1) & 127; kvh = unit & 1; } else { const int uu = unit - 512; b = uu >> 2; qb = (uu >> 1) & 1; kvh = uu & 1; }
    const int qrow0 = isctx ? NLAT + b * LCTX + qb * 128 : b * SEQ + qb * 128;
    const int lane = F.lane, r32 = lane & 31, hi = lane >> 5, g = F.wave >> 1, qh = F.wave & 1, head = kvh * 4 + g;
    int lt0 = 0, nloc = 0;
    if (!isctx) { lt0 = (qb == 0) ? 2 : 0; const int lt1 = (qb == 127) ? 4 : 6; nloc = lt1 - lt0; }
    const int ntile = nloc + 4;
    const int ctxrow0 = NLAT + b * LCTX;
    bf16x8 qr[2][4];
#pragma unroll
    for (int qk = 0; qk < 2; ++qk)
#pragma unroll
        for (int d0 = 0; d0 < 4; ++d0) qr[qk][d0] = *(const bf16x8*)(QB + (size_t)(qrow0 + qh * 64 + qk * 32 + r32) * 512 + head * 64 + d0 * 16 + hi * 8);
    const float sink2 = sinkv[head] * LOG2E;
    float mrun[2] = {sink2, sink2}, lrun[2] = {hi == 0 ? 1.f : 0.f, hi == 0 ? 1.f : 0.f};
    f32x16 o[2][2];
#pragma unroll
    for (int qk = 0; qk < 2; ++qk)
#pragma unroll
        for (int db = 0; db < 2; ++db)
#pragma unroll
            for (int r = 0; r < 16; ++r) o[qk][db][r] = 0.f;
    const int kr = F.tid >> 3, ch = F.tid & 7;
    u32x4 kreg, vreg;
#define ATT_TROW(t) ((t) < nloc ? (b * SEQ + qb * 128 - 128 + 64 * (lt0 + (t))) : (ctxrow0 + 64 * ((t) - nloc)))
#define ATT_LOAD(t) do { const bf16_t* p_ = KVB + (size_t)(ATT_TROW(t) + kr) * 256 + kvh * 64 + ch * 8; kreg = *(const u32x4*)p_; vreg = *(const u32x4*)(p_ + 128); } while (0)
#define ATT_STORE(buf) do { LAS unsigned char* kb_ = F.lds + (buf) * BUFB; *(LAS u32x4*)(kb_ + kr * KP + ch * 16) = kreg; LAS unsigned char* vb_ = kb_ + 64 * KP + kr * 2; \
        _Pragma("unroll") for (int e_ = 0; e_ < 4; ++e_) { *(LAS unsigned short*)(vb_ + (ch * 8 + 2 * e_) * KP) = (unsigned short)(vreg[e_] & 0xffffu); *(LAS unsigned short*)(vb_ + (ch * 8 + 2 * e_ + 1) * KP) = (unsigned short)(vreg[e_] >> 16); } } while (0)
    __syncthreads();
    ATT_LOAD(0); ATT_STORE(0);
    __syncthreads();
#pragma unroll 1
    for (int t = 0; t < ntile; ++t) {
        const int buf = t & 1;
        if (t + 1 < ntile) ATT_LOAD(t + 1);
        const bool loc = t < nloc; const int kp0 = loc ? -128 + 64 * (lt0 + t) : 0;
        const LAS unsigned char* Kb = F.lds + buf * BUFB; const LAS unsigned char* Vb = Kb + 64 * KP;
        bool rel[2] = {true, true}, needmask[2] = {false, false};
        if (loc) {
#pragma unroll
            for (int kh = 0; kh < 2; ++kh) { const int k0 = kp0 + 32 * kh, qmin = qh * 64, qmax = qh * 64 + 63;
                rel[kh] = !((k0 - qmax > 128) || (qmin - (k0 + 31) > 128)); needmask[kh] = (k0 + 31 - qmin > 128) || (qmax - k0 > 128); } }
        if (rel[0] || rel[1]) {
            f32x16 p[2][2];
#pragma unroll
            for (int kh = 0; kh < 2; ++kh) if (rel[kh]) {
                bf16x8 kf[4];
#pragma unroll
                for (int d0 = 0; d0 < 4; ++d0) kf[d0] = *(const LAS bf16x8*)(Kb + (kh * 32 + r32) * KP + (d0 * 16 + hi * 8) * 2);
#pragma unroll
                for (int qk = 0; qk < 2; ++qk) {
                    f32x16 sacc;
#pragma unroll
                    for (int r = 0; r < 16; ++r) sacc[r] = 0.f;
#pragma unroll
                    for (int d0 = 0; d0 < 4; ++d0) sacc = __builtin_amdgcn_mfma_f32_32x32x16_bf16(kf[d0], qr[qk][d0], sacc, 0, 0, 0);
                    p[kh][qk] = sacc; } }
#pragma unroll
            for (int qk = 0; qk < 2; ++qk) {
                const int qp = qh * 64 + qk * 32 + r32;
                float mx = -1.0e30f;
#pragma unroll
                for (int kh = 0; kh < 2; ++kh) if (rel[kh]) {
                    if (needmask[kh]) {
#pragma unroll
                        for (int r = 0; r < 16; ++r) { const int dlt = kp0 + kh * 32 + crow(r, hi) - qp; if (dlt > 128 || dlt < -128) p[kh][qk][r] = -1.0e30f; } }
#pragma unroll
                    for (int r = 0; r < 16; ++r) mx = fmaxf(mx, p[kh][qk][r]); }
                mx = fmaxf(mx, __shfl_xor(mx, 32));
                const float mnew = fmaxf(mrun[qk], mx), alpha = __builtin_amdgcn_exp2f(mrun[qk] - mnew);
                mrun[qk] = mnew;
                float ls = 0.f;
#pragma unroll
                for (int kh = 0; kh < 2; ++kh) if (rel[kh]) {
#pragma unroll
                    for (int r = 0; r < 16; ++r) { const float e = __builtin_amdgcn_exp2f(p[kh][qk][r] - mnew); p[kh][qk][r] = e; ls += e; } }
                lrun[qk] = lrun[qk] * alpha + ls;
                if (!__all(alpha == 1.0f)) {
#pragma unroll
                    for (int db = 0; db < 2; ++db)
#pragma unroll
                        for (int r = 0; r < 16; ++r) o[qk][db][r] *= alpha; }
            }
#pragma unroll
            for (int kh = 0; kh < 2; ++kh) if (rel[kh]) {
#pragma unroll
                for (int ks = 0; ks < 2; ++ks) {
                    bf16x8 pf[2];
#pragma unroll
                    for (int qk = 0; qk < 2; ++qk) { const u32x4 w = {pk2(p[kh][qk][8 * ks], p[kh][qk][8 * ks + 1]), pk2(p[kh][qk][8 * ks + 2], p[kh][qk][8 * ks + 3]), pk2(p[kh][qk][8 * ks + 4], p[kh][qk][8 * ks + 5]), pk2(p[kh][qk][8 * ks + 6], p[kh][qk][8 * ks + 7])};
                        pf[qk] = __builtin_bit_cast(bf16x8, w); }
                    const int kvb = kh * 32 + ks * 16 + 4 * hi;
#pragma unroll
                    for (int db = 0; db < 2; ++db) {
                        const LAS unsigned char* vp = Vb + (db * 32 + r32) * KP + kvb * 2;
                        const u32x2 lo = *(const LAS u32x2*)(vp), hi8 = *(const LAS u32x2*)(vp + 16);
                        const u32x4 vw = {lo[0], lo[1], hi8[0], hi8[1]};
                        const bf16x8 vf = __builtin_bit_cast(bf16x8, vw);
#pragma unroll
                        for (int qk = 0; qk < 2; ++qk) o[qk][db] = __builtin_amdgcn_mfma_f32_32x32x16_bf16(vf, pf[qk], o[qk][db], 0, 0, 0);
                    }
                }
            }
        }
        if (t + 1 < ntile) ATT_STORE(buf ^ 1);
        __syncthreads();
    }
#undef ATT_TROW
#undef ATT_LOAD
#undef ATT_STORE
#pragma unroll
    for (int qk = 0; qk < 2; ++qk) {
        const float lt = lrun[qk] + __shfl_xor(lrun[qk], 32); const float inv = 1.0f / lt;
        bf16_t* orow = CAT + (size_t)(qrow0 + qh * 64 + qk * 32 + r32) * D + head * 64;
#pragma unroll
        for (int db = 0; db < 2; ++db)
#pragma unroll
            for (int jg = 0; jg < 4; ++jg) { const int d = db * 32 + 8 * jg + 4 * hi;
                *(u32x2*)(orow + d) = (u32x2){pk2(o[qk][db][4 * jg] * inv, o[qk][db][4 * jg + 1] * inv), pk2(o[qk][db][4 * jg + 2] * inv, o[qk][db][4 * jg + 3] * inv)}; }
    }
}

__device__ __forceinline__ void sgu_unit(const Frame& F, const Args& a, int l, int chunk) {
    const bf16_t* VST = (const bf16_t*)(opq(F.ws) + O_VST); const bf16_t* UB = (const bf16_t*)(opq(F.ws) + O_UB); bf16_t* CAT = (bf16_t*)(opq(F.ws) + O_CAT);
    const int lane = F.lane, r32 = lane & 31, hi = lane >> 5, g = F.wave >> 1, ih = F.wave & 1; const int R0 = chunk * 128;
    const float* ws = ldin(10) + ((size_t)l * 4 + g) * 128 * 128; const float* bs = ldin(11) + ((size_t)l * 4 + g) * 128;
    f32x16 acc[2][2];
#pragma unroll
    for (int mb = 0; mb < 2; ++mb)
#pragma unroll
        for (int nb = 0; nb < 2; ++nb)
#pragma unroll
            for (int r = 0; r < 16; ++r) acc[mb][nb][r] = 0.f;
#pragma unroll 2
    for (int ks = 0; ks < 8; ++ks) {
        bf16x8 af[2], bfr[2];
#pragma unroll
        for (int mb = 0; mb < 2; ++mb) af[mb] = *(const bf16x8*)(VST + (size_t)(g * 64 + mb * 32 + r32) * NR + R0 + ks * 16 + hi * 8);
#pragma unroll
        for (int nb = 0; nb < 2; ++nb) { const float* wp = ws + (size_t)(ih * 64 + nb * 32 + r32) * 128 + ks * 16 + hi * 8; const f32x4 w0 = *(const f32x4*)wp, w1 = *(const f32x4*)(wp + 4);
            const u32x4 w = pack8(w0, w1); bfr[nb] = __builtin_bit_cast(bf16x8, w); }
#pragma unroll
        for (int mb = 0; mb < 2; ++mb)
#pragma unroll
            for (int nb = 0; nb < 2; ++nb) acc[mb][nb] = __builtin_amdgcn_mfma_f32_32x32x16_bf16(af[mb], bfr[nb], acc[mb][nb], 0, 0, 0);
    }
#pragma unroll
    for (int nb = 0; nb < 2; ++nb) { const int i = ih * 64 + nb * 32 + r32; const float bias = bs[i]; const size_t row = (size_t)R0 + i;
#pragma unroll
        for (int mb = 0; mb < 2; ++mb)
#pragma unroll
            for (int jg = 0; jg < 4; ++jg) { const int d = mb * 32 + 8 * jg + 4 * hi;
                const u32x2 uw = *(const u32x2*)(UB + row * 256 + g * 64 + d);
                const float z0 = (acc[mb][nb][4 * jg] + bias) * bflo(uw[0]), z1 = (acc[mb][nb][4 * jg + 1] + bias) * bfhi(uw[0]), z2 = (acc[mb][nb][4 * jg + 2] + bias) * bflo(uw[1]), z3 = (acc[mb][nb][4 * jg + 3] + bias) * bfhi(uw[1]);
                *(u32x2*)(CAT + row * D + 512 + g * 64 + d) = (u32x2){pk2(z0, z1), pk2(z2, z3)}; } }
}

struct SchFG {
    pg8::Deal d; const char* W; const char* HBp;
    __device__ __forceinline__ bool next(int i, Unit& u) const { int tm, tn; if (!d.get(i, tm, tn)) return false; const int b = tn >> 6, jp = tn & 63;
        u.A = W + (size_t)tm * 256 * D * 2; u.B = HBp + ((size_t)b * SEQ + 2 * jp) * D * 2; u.nt = 16; u.pm = tm; u.pn = tn; u.aux = tn; return true; }
};
struct SchFGc {
    pg8::Deal d; const char* W; const char* HBp;
    __device__ __forceinline__ bool next(int i, Unit& u) const { int tm, tn; if (!d.get(i, tm, tn)) return false;
        u.A = W + (size_t)tm * 256 * D * 2; u.B = HBp + ((size_t)NLAT + tn * LCTX) * D * 2; u.nt = 16; u.pm = tm; u.pn = tn; u.aux = tn; return true; }
};
struct SchDftA {
    pg8::Deal d; const char* T; const char* G;
    __device__ __forceinline__ bool next(int i, Unit& u) const { int tm, tn; if (!d.get(i, tm, tn)) return false; const int b = tn >> 7, jp = tn & 127;
        u.A = T; u.B = G + ((size_t)b * 128 * 256 + 2 * jp) * 256 * 2; u.nt = 4; u.pm = 0; u.pn = tn; u.aux = tn; return true; }
};
struct SchDftC {
    pg8::Deal d; const char* T; const char* AP;
    __device__ __forceinline__ bool next(int i, Unit& u) const { int tm, tn; if (!d.get(i, tm, tn)) return false;
        u.A = T; u.B = AP + (size_t)tn * 256 * 256 * 2; u.nt = 4; u.pm = 0; u.pn = tn; u.aux = tn; return true; }
};
struct SchDftX {
    pg8::Deal d; const char* T; const char* Gc;
    __device__ __forceinline__ bool next(int i, Unit& u) const { int tm, tn; if (!d.get(i, tm, tn)) return false;
        u.A = T; u.B = Gc + (size_t)tn * 256 * 512 * 2; u.nt = 8; u.pm = 0; u.pn = tn; u.aux = tn; return true; }
};
struct SchMerge {
    pg8::Deal d; const char* CATp; const char* Wb;
    __device__ __forceinline__ bool next(int i, Unit& u) const { int tm, tn; if (!d.get(i / 3, tm, tn)) return false; const int br = i % 3; const int koff = br == 0 ? 0 : br == 1 ? 512 : 768;
        u.A = CATp + ((size_t)tm * 256 * D + koff) * 2; u.B = Wb + ((size_t)tn * 256 * D + koff) * 2; u.nt = br == 0 ? 8 : 4; u.pm = tm; u.pn = tn; u.aux = br; return true; }
};
struct SchMergeOne {
    int tm, tn; const char* CATp; const char* Wb;
    __device__ __forceinline__ bool next(int i, Unit& u) const { if (i >= 3) return false; const int br = i; const int koff = br == 0 ? 0 : br == 1 ? 512 : 768;
        u.A = CATp + ((size_t)tm * 256 * D + koff) * 2; u.B = Wb + ((size_t)tn * 256 * D + koff) * 2; u.nt = br == 0 ? 8 : 4; u.pm = tm; u.pn = tn; u.aux = br; return true; }
};
struct SchOne2D {
    int tm, tn; const char* A; const char* B; size_t sA, sB; int nt;
    __device__ __forceinline__ bool next(int i, Unit& u) const { if (i >= 1) return false; u.A = A + (size_t)tm * sA; u.B = B + (size_t)tn * sB; u.nt = nt; u.pm = tm; u.pn = tn; u.aux = 0; return true; }
};
struct SchFfn {
    pg8::Deal d; const char* Ap; const char* Bp; size_t sA, sBe, sBt; int nt, nte;
    __device__ __forceinline__ bool next(int i, Unit& u) const { int tm, tn; if (!d.get(i, tm, tn)) return false; const int e = tm / nte; tm = e * ETILES + (tm - e * nte);
        u.A = Ap + (size_t)tm * sA; u.B = Bp + (size_t)e * sBe + (size_t)tn * sBt; u.nt = nt; u.pm = tm; u.pn = tn; u.aux = e; return true; }
};

constexpr int XP_NTOT = NE * 96;
constexpr int XP_SPLIT = 1024;
constexpr int NST = 12;
constexpr int NPHASE = 1 + DEPTH * NST;
#define STAGE_FRAME(Fs) Frame Fs = F; { int t_ = F.wave * 64 + lane_id(); asm volatile("" : "+v"(t_)); Fs.tid = t_; Fs.lane = t_ & 63; }
__global__ void __launch_bounds__(NTHR, 2) mk_fwd(Args args) {
    extern __shared__ __attribute__((aligned(16))) unsigned char lds_raw[];
    Frame F;
    F.lds = (LAS unsigned char*)lds_raw;
    F.tid = threadIdx.x; F.lane = F.tid & 63; F.wave = __builtin_amdgcn_readfirstlane(F.tid >> 6); F.G = gridDim.x; F.blk = blockIdx.x; F.ws = args.ws;
    volatile LAS unsigned* MISC = (volatile LAS unsigned*)(F.lds + MISC_OFF);
    for (int u = F.tid; u < (LDS_BYTES - RING_BYTES) / 4; u += NTHR) ((LAS unsigned*)(F.lds + RING_BYTES))[u] = 0u;
    __syncthreads();
    unsigned* ctl = (unsigned*)(F.ws + O_CTL);
    const int lo = args.ph_lo, hi = args.ph_hi;
    XcdBarrier bar; bar.bar = ctl + CW_BAR; bar.x = 0; bar.st = nullptr;
    if (hi - lo > 1) bar = xcd_barrier_post(ctl + CW_BAR, MISC + 8);
#ifndef STAGE_MASK
#define STAGE_MASK 0x1fff
#endif
#define SON(s) (((STAGE_MASK) >> (s)) & 1)
#ifndef SITE_MASK
#define SITE_MASK 0xffff
#endif
#define SITE_ON(s) (((SITE_MASK) >> (s)) & 1)
#ifndef DUP_STAGE
#define DUP_STAGE -1
#endif
#define REPS(s) ((DUP_STAGE) == (s) ? 2 : 1)
#define IN(k) (lo <= (k) && (k) < hi)
    volatile LAS unsigned* fw = MISC + 16;
#define SEAM_MAXL(k) ((k) == 0 ? 1 : ((((k) - 1) % NST) >= 11 ? ((k) - 1) / NST + 2 : ((k) - 1) / NST + 1))
#define SEAM(k) do { if (IN(k) && IN((k) + 1)) { STAGE_FRAME(Fb); const int ml_ = SEAM_MAXL(k); xcd_barrier_fill(bar, Fb, ctl, fw, ml_ < DEPTH - 1 ? ml_ : DEPTH - 1); } } while (0)
    const int gw = F.blk * NWAVES + F.wave, NGW = F.G * NWAVES;

    if (SON(12) && IN(0)) for (int rep = 0; rep < REPS(12); ++rep) {
        STAGE_FRAME(Fs);
        modvec_units(Fs, args);
    }
    SEAM(0);

#pragma unroll 1
    for (int l = 0; l < DEPTH; ++l) {
        const int pb = 1 + l * NST;

        if (SON(0) && IN(pb + 0) && l == 0) { STAGE_FRAME(Fs); phase_norm1_in(Fs, args); __syncthreads();
            tables(Fs); convert_nonexpert(Fs, args, 0, gw, NGW); for (int u = F.blk; u < 256; u += F.G) fold_unit(Fs, args, 0, u); }
        if (l == 0) SEAM(pb + 0);

        if (SON(1) && IN(pb + 1)) for (int rep = 0; rep < REPS(1); ++rep) {
            unsigned char* ws = opq(F.ws);
            const char* btin = (const char*)(ws + O_BTIN + (size_t)(l & 1) * SZ_BTIN); const char* HBc = (const char*)(ws + O_HB);
            const pg8::Geom gN{D, D, 128u * D * 2u, 128u * D * 2u};
            int off = 0; const int nMr = (l == DEPTH - 1) ? 128 : 130;
            if (SITE_ON(1)) { pg8::Sch2D S; S.d.init(130, 4, F.G, F.blk, off); S.A = HBc; S.B = btin; S.sA = (size_t)256 * D * 2; S.sB = (size_t)256 * D * 2; S.nt = 16;
              EpiQKVU E{(bf16_t*)(ws + O_QB), (bf16_t*)(ws + O_KVB), (bf16_t*)(ws + O_UB), (const float*)(ws + O_ROPEC), (const float*)(ws + O_ROPES), 0.125f * LOG2E}; pg8::gemm_phase(F.lds, F.wave, gN, S, E); off += 520; }
            if (SITE_ON(4)) { pg8::Sch2D S; S.d.init(1, nMr, F.G, F.blk, off); S.A = btin + (size_t)1024 * D * 2; S.B = HBc; S.sA = 0; S.sB = (size_t)256 * D * 2; S.nt = 16;
              EpiVsT E{(bf16_t*)(ws + O_VST)}; pg8::gemm_phase(F.lds, F.wave, gN, S, E); off += nMr; }
            if (SITE_ON(5)) { SchFG S; S.d.init(2, 128, F.G, F.blk, off); S.W = btin + (size_t)1280 * D * 2; S.HBp = HBc;
              const pg8::Geom gF{D, 128 * D, 128u * D * 2u, (unsigned)(D * 2)};
              EpiFG E{(bf16_t*)(ws + O_GB)}; pg8::gemm_phase(F.lds, F.wave, gF, S, E); off += 256; }
            if (SITE_ON(6) && l != DEPTH - 1) { SchFGc S; S.d.init(2, 2, F.G, F.blk, off); S.W = btin + (size_t)1280 * D * 2; S.HBp = HBc;
              EpiFGc E{(bf16_t*)(ws + O_GC)}; pg8::gemm_phase(F.lds, F.wave, gN, S, E); off += 4; }
            if (SITE_ON(0)) { pg8::Sch2D S; S.d.init(nMr, 12, F.G, F.blk, off); S.A = (const char*)(ws + O_HB8); S.B = (const char*)(ws + O_BTG8 + (size_t)(l & 1) * 3072 * D); S.sA = (size_t)256 * D; S.sB = (size_t)256 * D; S.nt = 8;
              const pg8::Geom g8{D / 2, D / 2, 128u * D, 128u * D};
              EpiAct<4> E{(bf16_t*)(ws + O_GATES), 3072, 1.0f / 32.0f}; pg8::gemm_phase<EpiAct<4>, pg8::Sch2D, true>(F.lds, F.wave, g8, S, E); }
        }
        SEAM(pb + 1);

        if (SON(2) && IN(pb + 2)) for (int rep = 0; rep < REPS(2); ++rep) {
            unsigned char* ws = opq(F.ws);
            const bool hv = (l != DEPTH - 1); const bool heavy = hv && F.blk >= 8 && F.blk < 16; const int Gl = hv ? F.G - 8 : F.G, bl = (hv && F.blk >= 16) ? F.blk - 8 : F.blk;
            if (SITE_ON(8) && !heavy) { SchDftA S; S.d.init(1, 256, Gl, bl, 0); S.T = (const char*)(ws + O_TA); S.G = (const char*)(ws + O_GB);
              const pg8::Geom gA{256, 65536, 128u * 256u * 2u, 256u * 2u};
              EpiDftA E{(bf16_t*)(ws + O_AP), (const float*)(ws + O_TWC), (const float*)(ws + O_TWS)}; pg8::gemm_phase(F.lds, F.wave, gA, S, E); }
            if (SITE_ON(9) && l != DEPTH - 1 && !heavy) { SchDftX S; S.d.init(1, 2, Gl, bl, 32); S.T = (const char*)(ws + O_TX); S.Gc = (const char*)(ws + O_GC);
              const pg8::Geom gX{512, 512, 128u * 512u * 2u, 128u * 512u * 2u};
              EpiDftX E{(bf16_t*)(ws + O_CAT)}; pg8::gemm_phase(F.lds, F.wave, gX, S, E); }
            __syncthreads();
            const float* sinkv = ldin(9) + (size_t)l * 8;
            { STAGE_FRAME(Fs); if (SITE_ON(10)) for (int u = (F.blk + F.G - 8) % F.G; u < (l == DEPTH - 1 ? 512 : 520); u += F.G) attn_unit(Fs, u, sinkv); }
            { STAGE_FRAME(Fs); if (SITE_ON(11) && !heavy) for (int c = (bl + Gl - 16) % Gl; c < (l == DEPTH - 1 ? 256 : 260); c += Gl) sgu_unit(Fs, args, l, c); }
        }
        SEAM(pb + 2);

        if (SON(3) && IN(pb + 3)) for (int rep = 0; rep < REPS(3); ++rep) {
            unsigned char* ws = opq(F.ws);
            SchDftC S; S.d.init(1, 256, F.G, F.blk, 0); S.T = (const char*)(ws + O_TC); S.AP = (const char*)(ws + O_AP);
            const pg8::Geom gC{256, 256, 128u * 256u * 2u, 128u * 256u * 2u};
            EpiDftC E{(bf16_t*)(ws + O_CAT)}; pg8::gemm_phase(F.lds, F.wave, gC, S, E);
        }
        SEAM(pb + 3);

        if (SON(4) && IN(pb + 4)) for (int rep = 0; rep < REPS(4); ++rep) {
            unsigned char* ws = opq(F.ws); const char* btbr = (const char*)(ws + O_BTBR + (size_t)(l & 1) * SZ_SQ);
            SchMerge S; S.d.init(128, 4, F.G, F.blk, 0);   S.CATp = (const char*)(ws + O_CAT); S.Wb = btbr;
            const pg8::Geom gN{D, D, 128u * D * 2u, 128u * D * 2u};
            EpiMerge E{(const unsigned char*)(ws + O_GATES), (bf16_t*)(ws + O_MB)}; pg8::gemm_phase(F.lds, F.wave, gN, S, E);
        }
        SEAM(pb + 4);

        if (SON(5) && IN(pb + 5)) for (int rep = 0; rep < ((DUP_STAGE) == 5 && l == 0 ? 2 : 1); ++rep) {
            unsigned char* ws = opq(F.ws); const char* bto = (const char*)(ws + O_BTO + (size_t)(l & 1) * SZ_SQ);
            const float* modv = (const float*)(ws + O_MODV) + (size_t)l * 3 * NMOD;
            pg8::Sch2D S; S.d.init(128, 4, F.G, F.blk, 0); S.A = (const char*)(ws + O_MB); S.B = bto; S.sA = (size_t)256 * D * 2; S.sB = (size_t)256 * D * 2; S.nt = 16;
            const pg8::Geom gN{D, D, 128u * D * 2u, 128u * D * 2u};
            EpiOut E{ldin(0), (bf16_t*)(ws + O_XW), modv, l == 0 ? 1 : 0}; pg8::gemm_phase(F.lds, F.wave, gN, S, E);
        }
        SEAM(pb + 5);

        if (SON(6) && IN(pb + 6)) for (int rep = 0; rep < REPS(6); ++rep) {
            const bool cx = (l != DEPTH - 1);
            if (cx && F.blk < 8) {
                unsigned char* ws = opq(F.ws);
                SchMergeOne S; S.tm = 128 + (F.blk >> 2); S.tn = F.blk & 3; S.CATp = (const char*)(ws + O_CAT); S.Wb = (const char*)(ws + O_BTBR + (size_t)(l & 1) * SZ_SQ);
                const pg8::Geom gN{D, D, 128u * D * 2u, 128u * D * 2u};
                EpiMerge E{(const unsigned char*)(ws + O_GATES), (bf16_t*)(ws + O_MB)}; pg8::gemm_phase(F.lds, F.wave, gN, S, E);
            } else { STAGE_FRAME(Fs); const int w0 = cx ? 8 : 0; phase_norm2(Fs, args, l, 0, NLAT, (F.blk - w0) * NWAVES + F.wave, (F.G - w0) * NWAVES); }
        }
        SEAM(pb + 6);

        if (SON(7) && IN(pb + 7)) for (int rep = 0; rep < REPS(7); ++rep) {
            { STAGE_FRAME(Fs); for (int u = F.blk; u < 32; u += F.G) select_unit(Fs, u); }
            if (F.blk < 32) wg_signal(ctl + CW_CNT + 64 * l + 16, F.wave); else __syncthreads();
            const bool cx = (l != DEPTH - 1); const int nconv = cx ? F.G - 8 : F.G;
            if (cx && F.blk >= nconv) {
                unsigned char* ws = opq(F.ws); const int j = F.blk - nconv;
                SchOne2D S; S.tm = 128 + (j >> 2); S.tn = j & 3; S.A = (const char*)(ws + O_MB); S.B = (const char*)(ws + O_BTO + (size_t)(l & 1) * SZ_SQ); S.sA = (size_t)256 * D * 2; S.sB = (size_t)256 * D * 2; S.nt = 16;
                const pg8::Geom gN{D, D, 128u * D * 2u, 128u * D * 2u};
                const float* modv = (const float*)(ws + O_MODV) + (size_t)l * 3 * NMOD;
                EpiOut E{ldin(2) - (size_t)NLAT * D, (bf16_t*)(ws + O_XW), modv, l == 0 ? 1 : 0}; pg8::gemm_phase(F.lds, F.wave, gN, S, E);
                wg_signal(ctl + CW_CNT + 64 * l + 32, F.wave); wg_wait(ctl + CW_CNT + 64 * l + 32, 8u, F.wave);
                { STAGE_FRAME(Fs); phase_norm2(Fs, args, l, NLAT, NR, j * NWAVES + F.wave, 8 * NWAVES); wg_signal(ctl + CW_CNT + 64 * l, F.wave); }
            }
            __syncthreads();
            { STAGE_FRAME(Fs); while (fill_one(Fs, ctl, fw, l)) {} }
            __syncthreads();
            if (l + 1 < DEPTH && F.blk < nconv) { STAGE_FRAME(Fs); convert_nonexpert(Fs, args, l + 1, F.blk * NWAVES + F.wave, nconv * NWAVES); for (int u = (F.blk + nconv - 32) % nconv; u < 256; u += nconv) fold_unit(Fs, args, l + 1, u); }
        }

        if (SON(8) && IN(pb + 8)) for (int rep = 0; rep < REPS(8); ++rep) {
            const bool cx = (l != DEPTH - 1); unsigned* cnt = ctl + CW_CNT + 64 * l;
            wg_wait(cnt + 16, 32u, F.wave);
            { STAGE_FRAME(Fs); phase_gather(Fs, true); }
            if (cx && F.blk >= 32 && F.blk < 64) { wg_wait(cnt, 8u, F.wave); STAGE_FRAME(Fs); select_unit(Fs, 32 + F.blk - 32); }
        }
        SEAM(pb + 8);

        if (SON(9) && IN(pb + 9)) for (int rep = 0; rep < REPS(9); ++rep) {
            unsigned char* ws = opq(F.ws);
            SchFfn S; S.nte = (l == DEPTH - 1) ? 16 : ETILES; S.d.init(NE * S.nte, 16, F.G, F.blk, 0); S.Ap = (const char*)(ws + O_XE); S.Bp = (const char*)(ws + O_BTGU) + (size_t)(l & 1) * SZ_GU8; S.sA = (size_t)256 * D; S.sBe = (size_t)4096 * D; S.sBt = (size_t)256 * D; S.nt = 8;
            const pg8::Geom g8{D / 2, D / 2, 128u * D, 128u * D};
            EpiFfn1 E{(bf16_t*)(ws + O_ACT)}; pg8::gemm_phase<EpiFfn1, SchFfn, true>(F.lds, F.wave, g8, S, E);
        }
        SEAM(pb + 9);

        if (SON(10) && IN(pb + 10)) for (int rep = 0; rep < REPS(10); ++rep) {
            unsigned char* ws = opq(F.ws);
            SchFfn S; S.nte = (l == DEPTH - 1) ? 16 : ETILES; S.d.init(NE * S.nte, 4, F.G, F.blk, 0); S.Ap = (const char*)(ws + O_ACT); S.Bp = (const char*)(ws + O_BTD) + (size_t)(l & 1) * SZ_D8; S.sA = (size_t)256 * FF; S.sBe = (size_t)D * FF; S.sBt = (size_t)256 * FF; S.nt = 16;
            const pg8::Geom gD{FF / 2, FF / 2, 128u * FF, 128u * FF};
            EpiStoreScaled E{(bf16_t*)(ws + O_YB), D, 1.0f / 32.0f};       pg8::gemm_phase<EpiStoreScaled, SchFfn, true>(F.lds, F.wave, gD, S, E);
        }
        SEAM(pb + 10);

        if (SON(11) && IN(pb + 11)) { STAGE_FRAME(Fs); phase_combine(Fs, args, l); }
        if (l + 1 < DEPTH) SEAM(pb + 11);
    }
#undef IN
#undef SEAM
}

extern "C" void kernel_launch(void* const* d_in, const int* in_sizes, int n_in, void* d_out, int out_size, void* d_ws, size_t ws_size, hipStream_t stream) {
    static int grid = 0;
    if (grid == 0) {
        if (n_in != 21 || out_size != NLAT * D || ws_size < O_END) { fprintf(stderr, "kernel_launch: unexpected shapes (n_in %d out %d ws %zu need %zu)\n", n_in, out_size, ws_size, (size_t)O_END); grid = -1; return; }
        int dev = 0, cus = 0;
        if (hipGetDevice(&dev) != hipSuccess || hipDeviceGetAttribute(&cus, hipDeviceAttributeMultiprocessorCount, dev) != hipSuccess) { grid = -1; return; }
        if (hipFuncSetAttribute((const void*)mk_fwd, hipFuncAttributeMaxDynamicSharedMemorySize, LDS_BYTES) != hipSuccess) { fprintf(stderr, "kernel_launch: hipFuncSetAttribute failed\n"); grid = -1; return; }
        int per_cu = 0;
        if (hipOccupancyMaxActiveBlocksPerMultiprocessor(&per_cu, (const void*)mk_fwd, NTHR, LDS_BYTES) != hipSuccess || per_cu < 1) fprintf(stderr, "kernel_launch: occupancy query reports %d\n", per_cu);
        (void)hipGetLastError();
        grid = cus;
    }
    if (grid < 0) return;
    (void)hipMemsetAsync((char*)d_ws + O_CTL, 0, CTL_BYTES, stream);
    Args a{};
    for (int i = 0; i < 21; ++i) a.in[i] = (const float*)d_in[i];
    a.out = (float*)d_out; a.ws = (unsigned char*)d_ws;
#if MK_MULTI
    for (int p = 0; p < NPHASE; ++p) {
        if (p > 0) { const int l = (p - 1) / NST, s = (p - 1) % NST; if (s == 0 && l > 0) continue; }
        a.ph_lo = p; a.ph_hi = p + 1;
        hipLaunchKernelGGL(mk_fwd, dim3(grid), dim3(NTHR), LDS_BYTES, stream, a);
    }
#else
    a.ph_lo = 0; a.ph_hi = NPHASE;
    hipLaunchKernelGGL(mk_fwd, dim3(grid), dim3(NTHR), LDS_BYTES, stream, a);
#endif
}
```

```cpp
#include <hip/hip_runtime.h>
#include <cstdio>
#include <cstdint>
#include <type_traits>

#ifndef MK_MULTI
#define MK_MULTI 0
#endif

#define LAS __attribute__((address_space(3)))
#define GAS __attribute__((address_space(1)))
typedef unsigned short bf16_t;
typedef short bf16x8 __attribute__((ext_vector_type(8)));
typedef short s16x4 __attribute__((ext_vector_type(4)));
typedef float f32x2 __attribute__((ext_vector_type(2)));
typedef float f32x4 __attribute__((ext_vector_type(4)));
typedef float f32x16 __attribute__((ext_vector_type(16)));
typedef unsigned u32x4 __attribute__((ext_vector_type(4)));
typedef unsigned u32x2 __attribute__((ext_vector_type(2)));
typedef __bf16 bf16x2_t __attribute__((ext_vector_type(2)));
typedef int v4i_t __attribute__((ext_vector_type(4)));
typedef int v8i_t __attribute__((ext_vector_type(8)));

constexpr int D = 1024, SEQ = 16384, NLAT = 32768, LCTX = 256, NCTX = 512, NR = 33280, DEPTH = 4;
constexpr int INW = 4608, BTIN = 4864, NE = 16, FF = 2048, CAP = 2048, CAPC = 32, EROWS = 4352, ETILES = 17, NEROWS = NE * EROWS;
constexpr int NMOD = 6 * D;
constexpr float EPS = 1e-6f;
constexpr float LOG2E = 1.4426950408889634f;
constexpr int NWAVES = 8, NTHR = 512;

constexpr size_t al256(size_t x) { return (x + 255) & ~(size_t)255; }
constexpr size_t O_CTL = 0, CTL_BYTES = 1u << 20;
constexpr size_t O_MODV = O_CTL + CTL_BYTES;
constexpr size_t O_ROPEC = al256(O_MODV + (size_t)DEPTH * 3 * NMOD * 4);
constexpr size_t O_ROPES = al256(O_ROPEC + (size_t)SEQ * 32 * 4);
constexpr size_t O_TWC = al256(O_ROPES + (size_t)SEQ * 32 * 4);
constexpr size_t O_TWS = al256(O_TWC + 128 * 128 * 4);
constexpr size_t O_TA = al256(O_TWS + 128 * 128 * 4);
constexpr size_t O_TC = al256(O_TA + 256 * 256 * 2);
constexpr size_t O_TX = al256(O_TC + 256 * 256 * 2);
constexpr size_t O_BTIN = al256(O_TX + 256 * 512 * 2);
constexpr size_t SZ_BTIN = (size_t)BTIN * D * 2;
constexpr size_t O_BTBR = al256(O_BTIN + 2 * SZ_BTIN);
constexpr size_t SZ_SQ = (size_t)D * D * 2;
constexpr size_t O_BTO = al256(O_BTBR + 2 * SZ_SQ);
constexpr size_t O_BTGU = al256(O_BTO + 2 * SZ_SQ);
constexpr size_t O_BTD = al256(O_BTGU + (size_t)NE * 4096 * D * 2);
constexpr size_t O_HB = al256(O_BTD + (size_t)NE * D * FF * 2);
constexpr size_t O_QB = al256(O_HB + (size_t)NR * D * 2);
constexpr size_t O_KVB = al256(O_QB + (size_t)NR * 512 * 2);
constexpr size_t O_UB = al256(O_KVB + (size_t)NR * 256 * 2);
constexpr size_t O_VST = al256(O_UB + (size_t)NR * 256 * 2);
constexpr size_t O_GB = al256(O_VST + (size_t)NR * 256 * 2);
constexpr size_t O_GC = al256(O_GB + (size_t)2 * 128 * 256 * 256 * 2);
constexpr size_t O_GATES = al256(O_GC + (size_t)2 * 256 * 512 * 2);
constexpr size_t O_AP = al256(O_GATES + (size_t)NR * 3072 * 2);
constexpr size_t O_CAT = al256(O_AP + (size_t)2 * 128 * 256 * 256 * 2);
constexpr size_t O_MACC = al256(O_CAT + (size_t)NR * D * 2);
constexpr size_t O_MB = al256(O_MACC + (size_t)NR * D * 4);
constexpr size_t O_XW = al256(O_MB + (size_t)NR * D * 2);
constexpr size_t O_AFFL = al256(O_XW + (size_t)NR * D * 4);
constexpr size_t O_AFFC = al256(O_AFFL + (size_t)2 * NE * SEQ * 4);
constexpr size_t O_ROWSEL = al256(O_AFFC + (size_t)2 * NE * LCTX * 4);
constexpr size_t O_GSEL = al256(O_ROWSEL + (size_t)NE * EROWS * 4);
constexpr size_t O_SLOTOF = al256(O_GSEL + (size_t)NE * EROWS * 4);
constexpr size_t O_XE = al256(O_SLOTOF + (size_t)NE * NR * 4);
constexpr size_t O_ACT = al256(O_XE + (size_t)NEROWS * D * 2);
constexpr size_t O_YB = al256(O_ACT + (size_t)NEROWS * FF * 2);
constexpr size_t O_HB8 = al256(O_YB + (size_t)NEROWS * D * 2);
constexpr size_t O_BTG8 = al256(O_HB8 + (size_t)NR * D);
constexpr size_t O_END = al256(O_BTG8 + (size_t)2 * 3072 * D);

constexpr int CW_BAR = 4096;

constexpr int RING_BYTES = 131072;
constexpr int LDS_BYTES = 147456;
constexpr int MISC_OFF = LDS_BYTES - 256;

__device__ __forceinline__ int lane_id() { int l; asm volatile("v_mbcnt_lo_u32_b32 %0, -1, 0\n\tv_mbcnt_hi_u32_b32 %0, -1, %0" : "=v"(l)); return l; }
__device__ __forceinline__ unsigned f2bf(float f) { unsigned u = __builtin_bit_cast(unsigned, f); return (u + 0x7fffu + ((u >> 16) & 1u)) >> 16; }
__device__ __forceinline__ unsigned pk2(float lo, float hi) { f32x2 v = {lo, hi}; bf16x2_t b = __builtin_convertvector(v, bf16x2_t); return __builtin_bit_cast(unsigned, b); }
__device__ __forceinline__ unsigned pk4_fp8(float a, float b, float c, float d) { int w = 0; w = __builtin_amdgcn_cvt_pk_fp8_f32(a, b, w, false); w = __builtin_amdgcn_cvt_pk_fp8_f32(c, d, w, true); return (unsigned)w; }
__device__ __forceinline__ unsigned pk4_u8(f32x4 g) { unsigned q[4];
#pragma unroll
    for (int i = 0; i < 4; ++i) { q[i] = (unsigned)(g[i] * 255.0f + 0.5f); q[i] = q[i] < 1u ? 1u : (q[i] > 255u ? 255u : q[i]); }
    return q[0] | (q[1] << 8) | (q[2] << 16) | (q[3] << 24); }
__device__ __forceinline__ f32x4 u8x4_f(unsigned w) { return (f32x4){(float)(w & 0xffu), (float)((w >> 8) & 0xffu), (float)((w >> 16) & 0xffu), (float)(w >> 24)}; }
__device__ __forceinline__ float bflo(unsigned w) { return __builtin_bit_cast(float, w << 16); }
__device__ __forceinline__ float bfhi(unsigned w) { return __builtin_bit_cast(float, w & 0xffff0000u); }
__device__ __forceinline__ float wave_sum(float v) {
#pragma unroll
    for (int o = 1; o < 64; o <<= 1) v += __shfl_xor(v, o);
    return v;
}
__device__ __forceinline__ float fast_sigmoid(float z) { return __builtin_amdgcn_rcpf(1.0f + __builtin_amdgcn_exp2f(-z * LOG2E)); }
__device__ __forceinline__ float gelu_tanh(float x) { const float z = 1.5957691216057308f * (x + 0.044715f * x * x * x); return x * fast_sigmoid(z); }
__device__ __forceinline__ f32x4 gelu4(f32x4 v) { return (f32x4){gelu_tanh(v[0]), gelu_tanh(v[1]), gelu_tanh(v[2]), gelu_tanh(v[3])}; }
__device__ __forceinline__ f32x4 sigm4(f32x4 v) { return (f32x4){fast_sigmoid(v[0]), fast_sigmoid(v[1]), fast_sigmoid(v[2]), fast_sigmoid(v[3])}; }
__device__ __forceinline__ u32x4 pack8(f32x4 a, f32x4 b) { return (u32x4){pk2(a[0], a[1]), pk2(a[2], a[3]), pk2(b[0], b[1]), pk2(b[2], b[3])}; }

#ifndef PG8_SP2
#define PG8_SP2 0
#endif
namespace pg8 {
constexpr int BM = 256, BK = 64, HALF = 128, HTB = HALF * BK * 2, STAGE_BYTES = 8 * HTB;
__host__ __device__ __forceinline__ int lds_byte(int r, int c) { const int st = (r >> 4) * 2 + (c >> 5), rr = r & 15, cc = c & 31, ob = rr * 64 + cc * 2; return st * 1024 + (ob ^ (((ob >> 9) & 1) << 5)); }
__host__ __device__ __forceinline__ void stage_rc(int b, int& R, int& C) { const int st = b / 1024, sb = b % 1024, swz = sb ^ (((sb >> 9) & 1) << 5); R = (st >> 1) * 16 + swz / 64; C = (st & 1) * 32 + (swz % 64) / 2; }
__host__ __device__ __forceinline__ int perm32(int rho) { const int n = rho >> 4, i = rho & 15; return 8 * (i >> 2) + 4 * n + (i & 3); }

struct Unit { const char* A; const char* B; int nt; int pm, pn, aux; };
struct Geom { int lda, ldb; unsigned hstepA, hstepB; };

template <class Epi, class Sched, bool F8 = false>
__device__ __forceinline__ void gemm_phase(LAS unsigned char* lds, const int wave, const Geom g, const Sched& S, const Epi& E) {
    int tid_ = wave * 64 + lane_id(); asm volatile("" : "+v"(tid_));
    const int tid = tid_, wid = __builtin_amdgcn_readfirstlane(tid >> 6), lane = tid & 63, wr = wid >> 2, wc = wid & 3, fr = lane & 15, fq = lane >> 4;
    unsigned voffA[2], voffB[2];
#pragma unroll
    for (int i = 0; i < 2; ++i) { int R, C; stage_rc(tid * 16 + i * 8192, R, C); const int Rb = Epi::PERM ? ((R & ~31) + perm32(R & 31)) : R;
        voffA[i] = (unsigned)(R * g.lda + C) * 2u; voffB[i] = (unsigned)(Rb * g.ldb + C) * 2u; }
    const size_t kstep = (size_t)(BK * 2);
    const size_t hstepA = g.hstepA, hstepB = g.hstepB;
    const unsigned ldsw = (unsigned)wid * 1024u;
    const int aoff = lds_byte(wr * 64 + fr, fq * 8), boff = lds_byte(wc * 32 + fr, fq * 8);
#define PG8_SA(b, h) (((b) * 2 + (h)) * HTB)
#define PG8_SB(b, h) ((4 + (b) * 2 + (h)) * HTB)
#define PG8_STAGE(bufoff, gbase, voff) do { _Pragma("unroll") for (int _i = 0; _i < 2; ++_i) \
        __builtin_amdgcn_global_load_lds((const unsigned*)((const char*)(gbase) + (voff)[_i]), (LAS unsigned*)(lds + (bufoff) + ldsw + _i * 8192), 16, 0, 0); } while (0)
#define PG8_LD1(dst, off) do { if constexpr (F8) { const v4i_t lo_ = *(const LAS v4i_t*)(lds + (off)), hi_ = *(const LAS v4i_t*)(lds + (off) + 1024); (dst)[0] = __builtin_shufflevector(lo_, hi_, 0, 1, 2, 3, 4, 5, 6, 7); } \
        else { _Pragma("unroll") for (int k = 0; k < 2; ++k) (dst)[k] = *(const LAS frag_t*)(lds + (off) + k * 1024); } } while (0)
#define PG8_LDA(dst, b, h) do { _Pragma("unroll") for (int m = 0; m < 4; ++m) PG8_LD1(dst[m], PG8_SA(b, h) + aoff + m * 2048); } while (0)
#define PG8_LDB(dst, b, h) do { _Pragma("unroll") for (int n = 0; n < 2; ++n) PG8_LD1(dst[n], PG8_SB(b, h) + boff + n * 2048); } while (0)
#define PG8_MMA(ai, bj, At, Bt) do { __builtin_amdgcn_s_setprio(1); \
        if constexpr (F8) { _Pragma("unroll") for (int m = 0; m < 4; ++m) _Pragma("unroll") for (int n = 0; n < 2; ++n) \
            asm volatile("v_mfma_f32_16x16x128_f8f6f4 %0, %1, %2, %0" : "+v"(acc[ai][bj][m][n]) : "v"(Bt[n][0]), "v"(At[m][0])); } \
        else { _Pragma("unroll") for (int m = 0; m < 4; ++m) _Pragma("unroll") for (int n = 0; n < 2; ++n) _Pragma("unroll") for (int k = 0; k < 2; ++k) \
            acc[ai][bj][m][n] = __builtin_amdgcn_mfma_f32_16x16x32_bf16(Bt[n][k], At[m][k], acc[ai][bj][m][n], 0, 0, 0); } \
        __builtin_amdgcn_s_setprio(0); } while (0)
#define PG8_WAIT_V(n) asm volatile("s_waitcnt vmcnt(" #n ")" ::: "memory")
#define PG8_WAIT_L(n) asm volatile("s_waitcnt lgkmcnt(" #n ")" ::: "memory")
#define PG8_BAR __builtin_amdgcn_s_barrier()
#define PG8_SCHED __builtin_amdgcn_sched_barrier(0)
    Unit cur, nxt; int ui = 0;
    if (!S.next(0, cur)) return;
    f32x4 acc[2][2][4][2];
#pragma unroll
    for (int a = 0; a < 2; ++a)
#pragma unroll
        for (int b = 0; b < 2; ++b)
#pragma unroll
            for (int m = 0; m < 4; ++m)
#pragma unroll
                for (int n = 0; n < 2; ++n) acc[a][b][m][n] = (f32x4){0.f, 0.f, 0.f, 0.f};
    typedef typename std::conditional<F8, v8i_t, bf16x8>::type frag_t;
    frag_t At[4][F8 ? 1 : 2], B0[2][F8 ? 1 : 2], B1[2][F8 ? 1 : 2];
    const char* cA = cur.A; const char* cB = cur.B;
#if PG8_SP2
    PG8_STAGE(PG8_SB(0, 0), cB, voffB); PG8_STAGE(PG8_SB(0, 1), cB + hstepB, voffB); PG8_STAGE(PG8_SA(0, 0), cA, voffA); PG8_STAGE(PG8_SA(0, 1), cA + hstepA, voffA);
    if (wr == 1) PG8_BAR;
    PG8_WAIT_V(2); PG8_BAR;
    PG8_STAGE(PG8_SB(1, 0), cB + kstep, voffB); PG8_STAGE(PG8_SA(1, 0), cA + kstep, voffA); PG8_STAGE(PG8_SB(1, 1), cB + hstepB + kstep, voffB);
    PG8_WAIT_V(6); PG8_BAR;
#else
    PG8_STAGE(PG8_SB(0, 0), cB, voffB); PG8_STAGE(PG8_SA(0, 0), cA, voffA); PG8_STAGE(PG8_SB(0, 1), cB + hstepB, voffB); PG8_STAGE(PG8_SA(0, 1), cA + hstepA, voffA);
    if (wr == 1) PG8_BAR;
    PG8_WAIT_V(4); PG8_BAR;
    PG8_STAGE(PG8_SB(1, 0), cB + kstep, voffB); PG8_STAGE(PG8_SA(1, 0), cA + kstep, voffA); PG8_STAGE(PG8_SB(1, 1), cB + hstepB + kstep, voffB);
    PG8_WAIT_V(6); PG8_BAR;
#endif
    for (;;) {
        const bool has_next = S.next(ui + 1, nxt);
        const char* nA = has_next ? nxt.A : cA; const char* nB = has_next ? nxt.B : cB;
        const int nt = cur.nt;
#pragma unroll 1
        for (int t = 0; t < nt; t += 2) {
            const bool last = (t == nt - 2);
            const char* a1 = cA + (size_t)(t + 1) * kstep;
            const char* a2 = last ? nA : cA + (size_t)(t + 2) * kstep; const char* b2 = last ? nB : cB + (size_t)(t + 2) * kstep;
            const char* a3 = a2 + kstep; const char* b3 = b2 + kstep;
#if PG8_SP2
            PG8_LDB(B0, 0, 0); PG8_LDB(B1, 0, 1); PG8_SCHED; PG8_LDA(At, 0, 0); PG8_STAGE(PG8_SA(1, 1), a1 + hstepA, voffA);
            PG8_WAIT_V(8); PG8_WAIT_L(0); PG8_BAR; PG8_MMA(0, 0, At, B0); PG8_MMA(0, 1, At, B1); PG8_BAR; PG8_SCHED;
            PG8_LDA(At, 0, 1); PG8_STAGE(PG8_SB(0, 0), b2, voffB); PG8_STAGE(PG8_SB(0, 1), b2 + hstepB, voffB); PG8_STAGE(PG8_SA(0, 0), a2, voffA);
            PG8_WAIT_V(8); PG8_WAIT_L(0); PG8_BAR; PG8_MMA(1, 0, At, B0); PG8_MMA(1, 1, At, B1); PG8_BAR; PG8_SCHED;
            PG8_LDB(B0, 1, 0); PG8_LDB(B1, 1, 1); PG8_SCHED; PG8_LDA(At, 1, 0); PG8_STAGE(PG8_SA(0, 1), a2 + hstepA, voffA);
            PG8_WAIT_V(8); PG8_WAIT_L(0); PG8_BAR; PG8_MMA(0, 0, At, B0); PG8_MMA(0, 1, At, B1); PG8_BAR; PG8_SCHED;
            PG8_LDA(At, 1, 1); PG8_STAGE(PG8_SB(1, 0), b3, voffB); PG8_STAGE(PG8_SB(1, 1), b3 + hstepB, voffB); PG8_STAGE(PG8_SA(1, 0), a3, voffA);
            PG8_WAIT_V(8); PG8_WAIT_L(0); PG8_BAR; PG8_MMA(1, 0, At, B0); PG8_MMA(1, 1, At, B1); PG8_BAR; PG8_SCHED;
#else
            PG8_LDB(B0, 0, 0); PG8_SCHED; PG8_LDA(At, 0, 0); PG8_STAGE(PG8_SA(1, 1), a1 + hstepA, voffA);
            PG8_WAIT_L(8); PG8_BAR; PG8_WAIT_L(0); PG8_MMA(0, 0, At, B0); PG8_BAR; PG8_SCHED;
            PG8_LDB(B1, 0, 1); PG8_STAGE(PG8_SB(0, 0), b2, voffB);
            PG8_BAR; PG8_WAIT_L(0); PG8_MMA(0, 1, At, B1); PG8_BAR;
            PG8_LDA(At, 0, 1); PG8_STAGE(PG8_SA(0, 0), a2, voffA);
            PG8_BAR; PG8_WAIT_L(0); PG8_MMA(1, 0, At, B0); PG8_BAR; PG8_SCHED;
            PG8_STAGE(PG8_SB(0, 1), b2 + hstepB, voffB);
            PG8_WAIT_V(6); PG8_BAR; PG8_MMA(1, 1, At, B1); PG8_BAR;
            PG8_LDB(B0, 1, 0); PG8_SCHED; PG8_LDA(At, 1, 0); PG8_STAGE(PG8_SA(0, 1), a2 + hstepA, voffA);
            PG8_WAIT_L(8); PG8_BAR; PG8_WAIT_L(0); PG8_MMA(0, 0, At, B0); PG8_BAR; PG8_SCHED;
            PG8_LDB(B1, 1, 1); PG8_STAGE(PG8_SB(1, 0), b3, voffB);
            PG8_BAR; PG8_WAIT_L(0); PG8_MMA(0, 1, At, B1); PG8_BAR;
            PG8_LDA(At, 1, 1); PG8_STAGE(PG8_SA(1, 0), a3, voffA);
            PG8_BAR; PG8_WAIT_L(0); PG8_MMA(1, 0, At, B0); PG8_BAR; PG8_SCHED;
            PG8_STAGE(PG8_SB(1, 1), b3 + hstepB, voffB);
            PG8_WAIT_V(6); PG8_BAR; PG8_MMA(1, 1, At, B1); PG8_BAR;
#endif
        }
        if (wr == 0) PG8_BAR;
        if constexpr (F8) asm volatile("s_nop 15\n\ts_nop 7" ::: "memory");
        { const int l2 = lane_id(); E(acc, cur, wr, wc, l2 & 15, l2 >> 4); }
        if (!has_next) break;
        if (!E.keep(cur)) {
#pragma unroll
        for (int a = 0; a < 2; ++a)
#pragma unroll
            for (int b = 0; b < 2; ++b)
#pragma unroll
                for (int m = 0; m < 4; ++m)
#pragma unroll
                    for (int n = 0; n < 2; ++n) acc[a][b][m][n] = (f32x4){0.f, 0.f, 0.f, 0.f};
        }
        cur = nxt; cA = nA; cB = nB; ++ui;
        if (wr == 1) PG8_BAR;
    }
    PG8_WAIT_V(0);
    PG8_BAR;
#undef PG8_SA
#undef PG8_SB
#undef PG8_STAGE
#undef PG8_LDA
#undef PG8_LDB
#undef PG8_MMA
#undef PG8_LD1
#undef PG8_WAIT_V
#undef PG8_WAIT_L
#undef PG8_BAR
#undef PG8_SCHED
}

struct Deal {
    int nM, nN, nwg, G, c;
    __device__ __forceinline__ void init(int nM_, int nN_, int G_, int blk, int off) { nM = nM_; nN = nN_; nwg = nM_ * nN_; G = G_; c = (blk + G_ - (off % G_)) % G_; }
    __device__ __forceinline__ bool get(int i, int& tm, int& tn) const {
        const long L = (long)i * G + c; if (L >= nwg) return false;
        int w = (int)L; { const int q = nwg / 8, r = nwg % 8, x = w % 8, o = w / 8; w = (x < r ? x * (q + 1) : r * (q + 1) + (x - r) * q) + o; }
        const int nig = 8 * nN, gid = w / nig, fm = gid * 8, gsz = (nM - fm) < 8 ? (nM - fm) : 8;
        tm = fm + ((w % nig) % gsz); tn = (w % nig) / gsz; return true;
    }
};
struct Sch2D {
    Deal d; const char* A; const char* B; size_t sA, sB; int nt;
    __device__ __forceinline__ bool next(int i, Unit& u) const { int tm, tn; if (!d.get(i, tm, tn)) return false; u.A = A + (size_t)tm * sA; u.B = B + (size_t)tn * sB; u.nt = nt; u.pm = tm; u.pn = tn; u.aux = 0; return true; }
};
}
using pg8::Unit;

struct EpiQ {
    static constexpr bool PERM = true;
    bf16_t* Q; const float* rc; const float* rs; float scale;
    __device__ __forceinline__ bool keep(const Unit&) const { return false; }
    __device__ __forceinline__ void operator()(f32x4 (&acc)[2][2][4][2], const Unit& u, int wr, int wc, int fr, int fq) const {
        const int row0 = u.pm * 256 + wr * 64 + fr; const bool lat = u.pm < 128; const int t4 = (4 * (wc & 1) + fq) * 4;
#pragma unroll
        for (int ai = 0; ai < 2; ++ai)
#pragma unroll
            for (int m = 0; m < 4; ++m) { __builtin_amdgcn_sched_barrier(0); const int row = row0 + ai * 128 + m * 16;
                f32x4 c4 = {1.f, 1.f, 1.f, 1.f}, s4 = {0.f, 0.f, 0.f, 0.f};
                if (lat) { const int pos = row & (SEQ - 1); c4 = *(const f32x4*)(rc + pos * 32 + t4); s4 = *(const f32x4*)(rs + pos * 32 + t4); }
#pragma unroll
                for (int bj = 0; bj < 2; ++bj) { const f32x4 x1 = acc[ai][bj][m][0], x2 = acc[ai][bj][m][1];
                    const f32x4 o1 = (x1 * c4 - x2 * s4) * scale, o2 = (x2 * c4 + x1 * s4) * scale;
                    *(u32x4*)(Q + (size_t)row * 512 + u.pn * 256 + bj * 128 + wc * 32 + 8 * fq) = pack8(o1, o2); } }
    }
};
struct EpiKV {
    static constexpr bool PERM = true;
    bf16_t* KV; const float* rc; const float* rs;
    __device__ __forceinline__ bool keep(const Unit&) const { return false; }
    __device__ __forceinline__ void operator()(f32x4 (&acc)[2][2][4][2], const Unit& u, int wr, int wc, int fr, int fq) const {
        const int row0 = u.pm * 256 + wr * 64 + fr; const bool lat = u.pm < 128; const int t4 = (4 * (wc & 1) + fq) * 4;
#pragma unroll
        for (int ai = 0; ai < 2; ++ai)
#pragma unroll
            for (int m = 0; m < 4; ++m) { __builtin_amdgcn_sched_barrier(0); const int row = row0 + ai * 128 + m * 16;
                f32x4 c4 = {1.f, 1.f, 1.f, 1.f}, s4 = {0.f, 0.f, 0.f, 0.f};
                if (lat) { const int pos = row & (SEQ - 1); c4 = *(const f32x4*)(rc + pos * 32 + t4); s4 = *(const f32x4*)(rs + pos * 32 + t4); }
                { const f32x4 x1 = acc[ai][0][m][0], x2 = acc[ai][0][m][1];
                  *(u32x4*)(KV + (size_t)row * 256 + wc * 32 + 8 * fq) = pack8(x1 * c4 - x2 * s4, x2 * c4 + x1 * s4); }
                *(u32x4*)(KV + (size_t)row * 256 + 128 + wc * 32 + 8 * fq) = pack8(acc[ai][1][m][0], acc[ai][1][m][1]); }
    }
};
struct EpiQKVU {
    static constexpr bool PERM = true;
    bf16_t* Q; bf16_t* KV; bf16_t* U; const float* rc; const float* rs; float scale;
    __device__ __forceinline__ bool keep(const Unit&) const { return false; }
    __device__ __forceinline__ void operator()(f32x4 (&acc)[2][2][4][2], const Unit& u, int wr, int wc, int fr, int fq) const {
        const int row0 = u.pm * 256 + wr * 64 + fr; const bool lat = u.pm < 128; const int t4 = (4 * (wc & 1) + fq) * 4; const int kind = u.pn;
#pragma unroll
        for (int ai = 0; ai < 2; ++ai)
#pragma unroll
            for (int m = 0; m < 4; ++m) { __builtin_amdgcn_sched_barrier(0); const int row = row0 + ai * 128 + m * 16;
                if (kind == 3) {
#pragma unroll
                    for (int bj = 0; bj < 2; ++bj) *(u32x4*)(U + (size_t)row * 256 + bj * 128 + wc * 32 + 8 * fq) = pack8(gelu4(acc[ai][bj][m][0]), gelu4(acc[ai][bj][m][1]));
                } else {
                    f32x4 c4 = {1.f, 1.f, 1.f, 1.f}, s4 = {0.f, 0.f, 0.f, 0.f};
                    if (lat) { const int pos = row & (SEQ - 1); c4 = *(const f32x4*)(rc + pos * 32 + t4); s4 = *(const f32x4*)(rs + pos * 32 + t4); }
                    if (kind < 2) {
#pragma unroll
                        for (int bj = 0; bj < 2; ++bj) { const f32x4 x1 = acc[ai][bj][m][0], x2 = acc[ai][bj][m][1];
                            *(u32x4*)(Q + (size_t)row * 512 + kind * 256 + bj * 128 + wc * 32 + 8 * fq) = pack8((x1 * c4 - x2 * s4) * scale, (x2 * c4 + x1 * s4) * scale); }
                    } else {
                        const f32x4 x1 = acc[ai][0][m][0], x2 = acc[ai][0][m][1];
                        *(u32x4*)(KV + (size_t)row * 256 + wc * 32 + 8 * fq) = pack8(x1 * c4 - x2 * s4, x2 * c4 + x1 * s4);
                        *(u32x4*)(KV + (size_t)row * 256 + 128 + wc * 32 + 8 * fq) = pack8(acc[ai][1][m][0], acc[ai][1][m][1]); } } }
    }
};
template <int ACT> struct EpiAct {
    static constexpr bool PERM = true;
    bf16_t* O; int ldc; float scale;
    __device__ __forceinline__ bool keep(const Unit&) const { return false; }
    __device__ __forceinline__ void operator()(f32x4 (&acc)[2][2][4][2], const Unit& u, int wr, int wc, int fr, int fq) const {
        const int row0 = u.pm * 256 + wr * 64 + fr;
#pragma unroll
        for (int ai = 0; ai < 2; ++ai)
#pragma unroll
            for (int m = 0; m < 4; ++m) { __builtin_amdgcn_sched_barrier(0); bf16_t* rowp = O + (size_t)(row0 + ai * 128 + m * 16) * ldc + u.pn * 256 + wc * 32 + 8 * fq;
#pragma unroll
                for (int bj = 0; bj < 2; ++bj) { f32x4 v0 = acc[ai][bj][m][0], v1 = acc[ai][bj][m][1];
                    if (ACT == 0) { v0 = gelu4(v0); v1 = gelu4(v1); }
                    if (ACT == 1) { v0 = sigm4(v0); v1 = sigm4(v1); }
                    if (ACT == 3) { v0 *= scale; v1 *= scale; }
                    if (ACT == 5) { v0 *= scale; v1 *= scale;
                        *(u32x2*)((unsigned char*)O + (size_t)(row0 + ai * 128 + m * 16) * ldc + u.pn * 256 + wc * 32 + 8 * fq + bj * 128) = (u32x2){pk4_fp8(v0[0], v0[1], v0[2], v0[3]), pk4_fp8(v1[0], v1[1], v1[2], v1[3])}; continue; }
                    if (ACT == 4) { v0 = sigm4(v0 * scale); v1 = sigm4(v1 * scale);
                        *(u32x2*)((unsigned char*)O + (size_t)(row0 + ai * 128 + m * 16) * ldc + u.pn * 256 + wc * 32 + 8 * fq + bj * 128) = (u32x2){pk4_u8(v0), pk4_u8(v1)}; continue; }
                    *(u32x4*)(rowp + bj * 128) = pack8(v0, v1); } }
    }
};
struct EpiVsT {
    static constexpr bool PERM = true;
    bf16_t* VST;
    __device__ __forceinline__ bool keep(const Unit&) const { return false; }
    __device__ __forceinline__ void operator()(f32x4 (&acc)[2][2][4][2], const Unit& u, int wr, int wc, int fr, int fq) const {
#pragma unroll
        for (int ai = 0; ai < 2; ++ai)
#pragma unroll
            for (int bj = 0; bj < 2; ++bj)
#pragma unroll
                for (int n = 0; n < 2; ++n) { __builtin_amdgcn_sched_barrier(0);
                    f32x4 g[4]; f32x4 ss = {0.f, 0.f, 0.f, 0.f};
#pragma unroll
                    for (int m = 0; m < 4; ++m) { g[m] = gelu4(acc[ai][bj][m][n]); ss += g[m] * g[m]; }
#pragma unroll
                    for (int i = 0; i < 4; ++i) { float q = ss[i]; q += __shfl_xor(q, 1); q += __shfl_xor(q, 2); q += __shfl_xor(q, 4); q += __shfl_xor(q, 8);
                        ss[i] = __builtin_amdgcn_rsqf(q * (1.0f / 64.0f) + EPS); }
                    const size_t grow = (size_t)u.pn * 256 + bj * 128 + wc * 32 + 8 * fq + 4 * n;
#pragma unroll
                    for (int m = 0; m < 4; ++m) { const int ch = ai * 128 + wr * 64 + m * 16 + fr; const f32x4 y = g[m] * ss;
                        *(u32x2*)(VST + (size_t)ch * NR + grow) = (u32x2){pk2(y[0], y[1]), pk2(y[2], y[3])}; } }
    }
};
struct EpiFG {
    static constexpr bool PERM = true;
    bf16_t* G;
    __device__ __forceinline__ bool keep(const Unit&) const { return false; }
    __device__ __forceinline__ void operator()(f32x4 (&acc)[2][2][4][2], const Unit& u, int wr, int wc, int fr, int fq) const {
        const int b = u.aux >> 6, jp = u.aux & 63, rip = u.pm;
#pragma unroll
        for (int ai = 0; ai < 2; ++ai)
#pragma unroll
            for (int m = 0; m < 4; ++m) { __builtin_amdgcn_sched_barrier(0); const int gm = ai * 128 + wr * 64 + m * 16 + fr;
#pragma unroll
                for (int bj = 0; bj < 2; ++bj) { const int n2 = 2 * jp + bj;
                    *(u32x4*)(G + ((((size_t)(b * 128 + n2) * 256 + gm) * 2 + rip) * 128 + wc * 32 + 8 * fq)) = pack8(acc[ai][bj][m][0], acc[ai][bj][m][1]); } }
    }
};
struct EpiFGc {
    static constexpr bool PERM = true;
    bf16_t* Gc;
    __device__ __forceinline__ bool keep(const Unit&) const { return false; }
    __device__ __forceinline__ void operator()(f32x4 (&acc)[2][2][4][2], const Unit& u, int wr, int wc, int fr, int fq) const {
        const int b = u.aux, rip = u.pm;
#pragma unroll
        for (int ai = 0; ai < 2; ++ai)
#pragma unroll
            for (int m = 0; m < 4; ++m) { __builtin_amdgcn_sched_barrier(0); const int gm = ai * 128 + wr * 64 + m * 16 + fr;
#pragma unroll
                for (int bj = 0; bj < 2; ++bj)
                    *(u32x4*)(Gc + (((size_t)(b * 256 + gm) * 2 + rip) * 256 + bj * 128 + wc * 32 + 8 * fq)) = pack8(acc[ai][bj][m][0], acc[ai][bj][m][1]); }
    }
};
struct EpiDftA {
    static constexpr bool PERM = true;
    bf16_t* AP; const float* twc; const float* tws;
    __device__ __forceinline__ bool keep(const Unit&) const { return false; }
    __device__ __forceinline__ void operator()(f32x4 (&acc)[2][2][4][2], const Unit& u, int wr, int wc, int fr, int fq) const {
        const int b = u.aux >> 7, jp = u.aux & 127;
#pragma unroll
        for (int m = 0; m < 4; ++m) { __builtin_amdgcn_sched_barrier(0); const int k1 = wr * 64 + m * 16 + fr; const int n2 = wc * 32 + 8 * fq;
            const f32x4 c0 = *(const f32x4*)(twc + k1 * 128 + n2), c1 = *(const f32x4*)(twc + k1 * 128 + n2 + 4);
            const f32x4 s0 = *(const f32x4*)(tws + k1 * 128 + n2), s1 = *(const f32x4*)(tws + k1 * 128 + n2 + 4);
#pragma unroll
            for (int bj = 0; bj < 2; ++bj) { const int gm = 2 * jp + bj;
                const f32x4 re0 = acc[0][bj][m][0], re1 = acc[0][bj][m][1], im0 = acc[1][bj][m][0], im1 = acc[1][bj][m][1];
                bf16_t* p = AP + (((size_t)(b * 128 + k1) * 256 + gm) * 2) * 128 + n2;
                *(u32x4*)(p) = pack8(re0 * c0 + im0 * s0, re1 * c1 + im1 * s1);
                *(u32x4*)(p + 128) = pack8(im0 * c0 - re0 * s0, im1 * c1 - re1 * s1); }
            asm volatile("" ::: "memory"); }
    }
};
struct EpiDftC {
    static constexpr bool PERM = true;
    bf16_t* CAT;
    __device__ __forceinline__ bool keep(const Unit&) const { return false; }
    __device__ __forceinline__ void operator()(f32x4 (&acc)[2][2][4][2], const Unit& u, int wr, int wc, int fr, int fq) const {
        const int b = u.aux >> 7, k1 = u.aux & 127;
#pragma unroll
        for (int m = 0; m < 4; ++m) { __builtin_amdgcn_sched_barrier(0); const int k2 = wr * 64 + m * 16 + fr; const size_t row = (size_t)b * SEQ + k1 + 128 * k2;
#pragma unroll
            for (int bj = 0; bj < 2; ++bj) *(u32x4*)(CAT + row * D + 768 + bj * 128 + wc * 32 + 8 * fq) = pack8(acc[0][bj][m][0], acc[0][bj][m][1]); }
    }
};
struct EpiDftX {
    static constexpr bool PERM = true;
    bf16_t* CAT;
    __device__ __forceinline__ bool keep(const Unit&) const { return false; }
    __device__ __forceinline__ void operator()(f32x4 (&acc)[2][2][4][2], const Unit& u, int wr, int wc, int fr, int fq) const {
        const int b = u.aux;
#pragma unroll
        for (int ai = 0; ai < 2; ++ai)
#pragma unroll
            for (int m = 0; m < 4; ++m) { __builtin_amdgcn_sched_barrier(0); const size_t row = (size_t)NLAT + b * 256 + ai * 128 + wr * 64 + m * 16 + fr;
#pragma unroll
                for (int bj = 0; bj < 2; ++bj) *(u32x4*)(CAT + row * D + 768 + bj * 128 + wc * 32 + 8 * fq) = pack8(acc[ai][bj][m][0], acc[ai][bj][m][1]); }
    }
};
struct EpiMerge {
    static constexpr bool PERM = true;
    const unsigned char* GATES; bf16_t* MB;
    __device__ __forceinline__ bool keep(const Unit& u) const { return u.aux < 2; }
    __device__ __forceinline__ void operator()(f32x4 (&acc)[2][2][4][2], const Unit& u, int wr, int wc, int fr, int fq) const {
        const int br = u.aux; const int col0 = u.pn * 256 + wc * 32 + 8 * fq;
        const unsigned char* gp = GATES + (size_t)(u.pm * 256 + wr * 64 + fr) * 3072 + br * 1024 + col0;
        u32x2 gc[2], hc[2], gn[2], hn[2];
        gc[0] = *(const u32x2*)(gp); gc[1] = *(const u32x2*)(gp + 128); hc[0] = gc[0]; hc[1] = gc[1];
        if (br < 2) { hc[0] = *(const u32x2*)(gp + 1024); hc[1] = *(const u32x2*)(gp + 1024 + 128); }
#pragma unroll
        for (int grp = 0; grp < 8; ++grp) { const int ai = grp >> 2, m = grp & 3;
            if (grp < 7) { const unsigned char* np = gp + (size_t)(((grp + 1) >> 2) * 128 + ((grp + 1) & 3) * 16) * 3072;
                gn[0] = *(const u32x2*)(np); gn[1] = *(const u32x2*)(np + 128); hn[0] = gn[0]; hn[1] = gn[1];
                if (br < 2) { hn[0] = *(const u32x2*)(np + 1024); hn[1] = *(const u32x2*)(np + 1024 + 128); } }
            const size_t row = (size_t)(u.pm * 256 + wr * 64 + fr + ai * 128 + m * 16);
#pragma unroll
            for (int bj = 0; bj < 2; ++bj) { f32x4 g0 = u8x4_f(gc[bj][0]), g1 = u8x4_f(gc[bj][1]);
                if (br < 2) { const f32x4 h0 = u8x4_f(hc[bj][0]), h1 = u8x4_f(hc[bj][1]);
#pragma unroll
                    for (int i = 0; i < 4; ++i) { g0[i] *= __builtin_amdgcn_rcpf(h0[i]); g1[i] *= __builtin_amdgcn_rcpf(h1[i]); }
                    acc[ai][bj][m][0] *= g0; acc[ai][bj][m][1] *= g1; }
                else *(u32x4*)(MB + row * D + col0 + bj * 128) = pack8(acc[ai][bj][m][0] * (g0 * (1.0f / 255.0f)), acc[ai][bj][m][1] * (g1 * (1.0f / 255.0f))); }
            gc[0] = gn[0]; gc[1] = gn[1]; hc[0] = hn[0]; hc[1] = hn[1];
            __builtin_amdgcn_sched_barrier(0); }
    }
};
struct EpiOut {
    static constexpr bool PERM = true;
    const float* src32; bf16_t* XWb; const float* modv; int layer0;
    __device__ __forceinline__ bool keep(const Unit&) const { return false; }
    __device__ __forceinline__ void operator()(f32x4 (&acc)[2][2][4][2], const Unit& u, int wr, int wc, int fr, int fq) const {
        const int row0 = u.pm * 256 + wr * 64 + fr, col0 = u.pn * 256 + wc * 32 + 8 * fq;
        const float* gt = modv + (u.pm < 64 ? 0 : u.pm < 128 ? 1 : 2) * NMOD + 2 * D + col0;
        f32x4 g[2][2];
#pragma unroll
        for (int bj = 0; bj < 2; ++bj) { g[bj][0] = *(const f32x4*)(gt + bj * 128); g[bj][1] = *(const f32x4*)(gt + bj * 128 + 4); }
        if (layer0) {
#pragma unroll
            for (int ai = 0; ai < 2; ++ai)
#pragma unroll
                for (int m = 0; m < 4; ++m) { __builtin_amdgcn_sched_barrier(0); const size_t ro = (size_t)(row0 + ai * 128 + m * 16) * D + col0;
#pragma unroll
                    for (int bj = 0; bj < 2; ++bj) { const f32x4 x0 = *(const f32x4*)(src32 + ro + bj * 128), x1 = *(const f32x4*)(src32 + ro + bj * 128 + 4);
                        *(u32x4*)(XWb + ro + bj * 128) = pack8(x0 + g[bj][0] * acc[ai][bj][m][0], x1 + g[bj][1] * acc[ai][bj][m][1]); } }
        } else {
            u32x4 xc[2], xn[2];
            { const bf16_t* p = XWb + (size_t)row0 * D + col0; xc[0] = *(const u32x4*)(p); xc[1] = *(const u32x4*)(p + 128); }
#pragma unroll
            for (int grp = 0; grp < 8; ++grp) { const int ai = grp >> 2, m = grp & 3;
                if (grp < 7) { const bf16_t* np = XWb + (size_t)(row0 + ((grp + 1) >> 2) * 128 + ((grp + 1) & 3) * 16) * D + col0; xn[0] = *(const u32x4*)(np); xn[1] = *(const u32x4*)(np + 128); }
                bf16_t* dst = XWb + (size_t)(row0 + ai * 128 + m * 16) * D + col0;
#pragma unroll
                for (int bj = 0; bj < 2; ++bj) { const u32x4 w = xc[bj];
                    const f32x4 x0 = {bflo(w[0]), bfhi(w[0]), bflo(w[1]), bfhi(w[1])}, x1 = {bflo(w[2]), bfhi(w[2]), bflo(w[3]), bfhi(w[3])};
                    *(u32x4*)(dst + bj * 128) = pack8(x0 + g[bj][0] * acc[ai][bj][m][0], x1 + g[bj][1] * acc[ai][bj][m][1]); }
                xc[0] = xn[0]; xc[1] = xn[1];
                __builtin_amdgcn_sched_barrier(0); }
        }
    }
};
struct EpiFfn1 {
    static constexpr bool PERM = true;
    bf16_t* ACT;
    __device__ __forceinline__ bool keep(const Unit&) const { return false; }
    __device__ __forceinline__ void operator()(f32x4 (&acc)[2][2][4][2], const Unit& u, int wr, int wc, int fr, int fq) const {
        const int row0 = u.pm * 256 + wr * 64 + fr;
#pragma unroll
        for (int ai = 0; ai < 2; ++ai)
#pragma unroll
            for (int m = 0; m < 4; ++m) { __builtin_amdgcn_sched_barrier(0); const size_t row = (size_t)(row0 + ai * 128 + m * 16);
                f32x4 o[2];
#pragma unroll
                for (int n = 0; n < 2; ++n) { const f32x4 a = acc[ai][0][m][n] * 0.03125f, up = acc[ai][1][m][n] * 0.03125f; o[n] = a * sigm4(a) * up; }
                o[0] *= 8.0f; o[1] *= 8.0f;
                *(u32x2*)((unsigned char*)ACT + row * FF + u.pn * 128 + wc * 32 + 8 * fq) = (u32x2){pk4_fp8(o[0][0], o[0][1], o[0][2], o[0][3]), pk4_fp8(o[1][0], o[1][1], o[1][2], o[1][3])}; }
    }
};
typedef EpiAct<5> EpiStoreScaled;

#define XB_TMO      128
#define XB_XCNT(j)  (256  + 64 * (j))
#define XB_XSUB(j)  (1280 + 64 * (j))
#define XB_XGEN(j)  (2304 + 64 * (j))
#define XB_TOP      3328
#define XB_TOPGEN   3392
#define XCD_BAR_WORDS 3456
#define XB_SPIN_CAP (1u << 18)
__device__ __forceinline__ unsigned xb_ld(unsigned* p)              { return __hip_atomic_load(p, __ATOMIC_RELAXED, __HIP_MEMORY_SCOPE_AGENT); }
__device__ __forceinline__ unsigned xb_add(unsigned* p, unsigned v) { return __hip_atomic_fetch_add(p, v, __ATOMIC_RELAXED, __HIP_MEMORY_SCOPE_AGENT); }
__device__ __forceinline__ unsigned xb_xcc_id() { return (unsigned)__builtin_amdgcn_s_getreg((3 << 11) | 20) & 0xFu; }
#define XB_SPIN(cond, bar) do { unsigned _sp = 0; while (cond) { __builtin_amdgcn_s_sleep(1); \
    if ((++_sp & 255u) == 0u) { if (xb_ld(&(bar)[XB_TMO])) break; if (_sp > XB_SPIN_CAP) { atomicAdd(&(bar)[XB_TMO], 1u); break; } } } } while (0)
struct XcdBarrier { unsigned* bar; unsigned x; volatile LAS unsigned* st; };
__device__ __forceinline__ XcdBarrier xcd_barrier_post(unsigned* bar, volatile LAS unsigned* st) {
    XcdBarrier b; b.bar = bar; b.x = xb_xcc_id(); b.st = st;
    if (threadIdx.x == 0) (void)xb_add(&bar[XB_XCNT(b.x)], 1u);
    return b;
}
__device__ __forceinline__ void xcd_barrier_complete(unsigned* bar, unsigned x, unsigned& nloc, unsigned& nx) {
    const unsigned G = gridDim.x * gridDim.y * gridDim.z;
    unsigned sum, cnt, mine, sp = 0u;
    for (;;) {
        sum = 0u; cnt = 0u; mine = 0u;
#pragma unroll
        for (unsigned j = 0; j < 16; ++j) { const unsigned c = xb_ld(&bar[XB_XCNT(j)]); sum += c; cnt += (c > 0u) ? 1u : 0u; mine = (j == x) ? c : mine; }
        if (sum == G) break;
        __builtin_amdgcn_s_sleep(1);
        if ((++sp & 255u) == 0u) { if (xb_ld(&bar[XB_TMO])) break; if (sp > XB_SPIN_CAP) { atomicAdd(&bar[XB_TMO], 1u); break; } }
    }
    nloc = mine > 0u ? mine : 1u; nx = cnt > 0u ? cnt : 1u;
}
__device__ __forceinline__ void xcd_barrier(const XcdBarrier& b, const int wave) {
    const bool t0 = (wave == 0) && (lane_id() == 0);
    asm volatile("s_waitcnt vmcnt(0)" ::: "memory");
    __syncthreads();
    if (t0) {
        unsigned* bar = b.bar;
        __builtin_amdgcn_s_waitcnt(0);
        unsigned nloc = b.st[0], nx = b.st[1];
        if (nloc == 0u) { xcd_barrier_complete(bar, b.x, nloc, nx); b.st[0] = nloc; b.st[1] = nx; }
        const unsigned old = xb_add(&bar[XB_XSUB(b.x)], 1u);
        const unsigned gen = old / nloc;
        if (old + 1u == (gen + 1u) * nloc) {
            __builtin_amdgcn_fence(__ATOMIC_RELEASE, "agent");
            asm volatile("s_waitcnt vmcnt(0)" ::: "memory");
            const unsigned og = xb_add(&bar[XB_TOP], 1u);
            const unsigned tg = og / nx;
            if (og + 1u == (tg + 1u) * nx) xb_add(&bar[XB_TOPGEN], 1u);
            else XB_SPIN(xb_ld(&bar[XB_TOPGEN]) == tg, bar);
            __builtin_amdgcn_fence(__ATOMIC_ACQUIRE, "agent");
            xb_add(&bar[XB_XGEN(b.x)], 1u);
            asm volatile("s_waitcnt vmcnt(0)" ::: "memory");
        } else {
            XB_SPIN(xb_ld(&bar[XB_XGEN(b.x)]) == gen, bar);
            __builtin_amdgcn_fence(__ATOMIC_ACQUIRE, "agent");
            asm volatile("s_waitcnt vmcnt(0)" ::: "memory");
        }
    }
    __syncthreads();
}

constexpr int CW_CNT = 8192;
__device__ __forceinline__ void wg_signal(unsigned* cnt, const int wave) {
    asm volatile("s_waitcnt vmcnt(0)" ::: "memory"); __syncthreads();
    if (wave == 0 && lane_id() == 0) { __builtin_amdgcn_fence(__ATOMIC_RELEASE, "agent"); asm volatile("s_waitcnt vmcnt(0)" ::: "memory"); (void)xb_add(cnt, 1u); }
}
__device__ __forceinline__ void wg_wait(unsigned* cnt, unsigned need, const int wave) {
    if (wave == 0 && lane_id() == 0) { unsigned sp = 0; while (xb_ld(cnt) < need) { __builtin_amdgcn_s_sleep(2); if (++sp > (1u << 22)) break; }
        __builtin_amdgcn_fence(__ATOMIC_ACQUIRE, "agent"); asm volatile("s_waitcnt vmcnt(0)" ::: "memory"); }
    __syncthreads();
}

struct Args {
    const float* in[21];
    float* out; unsigned char* ws;
    int ph_lo, ph_hi;
};
struct Frame {
    LAS unsigned char* lds;
    int tid, lane, wave, G, blk;
    unsigned char* ws;
};


#define AS4 __attribute__((address_space(4)))
__device__ __forceinline__ const float* ldin(int i) { const char AS4* ka = (const char AS4*)__builtin_amdgcn_kernarg_segment_ptr(); asm volatile("" : "+s"(ka)); const float GAS* g = *(const float GAS* const AS4*)(ka + 8 * i); asm volatile("" : "+s"(g)); return (const float*)g; }
__device__ __forceinline__ float* ldout() { const char AS4* ka = (const char AS4*)__builtin_amdgcn_kernarg_segment_ptr(); asm volatile("" : "+s"(ka)); float GAS* g = *(float GAS* const AS4*)(ka + 8 * 21); asm volatile("" : "+s"(g)); return (float*)g; }
__device__ __forceinline__ unsigned char* opq(unsigned char* p) { GAS unsigned char* g = (GAS unsigned char*)p; asm volatile("" : "+s"(g)); return (unsigned char*)g; }

__device__ __forceinline__ int headperm(int n) { const int h = n & ~63, i = n & 63; return h + (i < 32 ? 8 * (i >> 2) + (i & 3) : 8 * ((i - 32) >> 2) + 4 + (i & 3)); }
template <int MODE> __device__ __forceinline__ int maprow(int n, int roff) {
    if (MODE == 0) return n + roff;
    if (MODE == 1) { if (n < 640) return headperm(n); if (n < 1280) return n; if (n < 1536) return -1; return n + 256; }
    if (MODE == 2) return (n >> 7) * 256 + (n & 127);
    return (n >> 7) * 256 + 128 + (n & 127);
}
template <int MODE> __device__ __forceinline__ void xpose_item(const float* W, int N, bf16_t* WT, int ldt, int koff, int roff, LAS float* scr, int item, int lane, unsigned char* W8 = nullptr) {
    const int nblk = N / 32, kb = item / nblk, nb = item % nblk, k0 = 64 * kb, n0 = 32 * nb;
    if (MODE == 1 && n0 >= 1280 && n0 < 1536) return;
    { const int lr = lane >> 3, lc = (lane & 7) * 4; f32x4 R[8];
#pragma unroll
      for (int i = 0; i < 8; ++i) R[i] = *(const f32x4*)(W + (size_t)(k0 + lr + 8 * i) * N + n0 + lc);
#pragma unroll
      for (int i = 0; i < 8; ++i) { LAS float* p = scr + (lr + 8 * i) * 33 + lc; p[0] = R[i][0]; p[1] = R[i][1]; p[2] = R[i][2]; p[3] = R[i][3]; } }
    asm volatile("s_waitcnt lgkmcnt(0)" ::: "memory");
    const int c = lane & 7;
#pragma unroll
    for (int j = 0; j < 4; ++j) { const int n = (lane >> 3) + 8 * j; const LAS float* s = scr + (8 * c) * 33 + n;
        if (MODE == 1 && n0 >= 1536) {
            *(u32x2*)(W8 + (size_t)(n0 + n - 1536) * 1024 + k0 + 8 * c) = (u32x2){pk4_fp8(s[0 * 33] * 32.0f, s[1 * 33] * 32.0f, s[2 * 33] * 32.0f, s[3 * 33] * 32.0f), pk4_fp8(s[4 * 33] * 32.0f, s[5 * 33] * 32.0f, s[6 * 33] * 32.0f, s[7 * 33] * 32.0f)};
            continue; }
        u32x4 o; o.x = pk2(s[0 * 33], s[1 * 33]); o.y = pk2(s[2 * 33], s[3 * 33]); o.z = pk2(s[4 * 33], s[5 * 33]); o.w = pk2(s[6 * 33], s[7 * 33]);
        *(u32x4*)(WT + (size_t)maprow<MODE>(n0 + n, roff) * ldt + koff + k0 + 8 * c) = o; }
    asm volatile("s_waitcnt lgkmcnt(0)" ::: "memory");
}
__device__ __forceinline__ void convert_nonexpert(const Frame& F, const Args& a, int l, int gw, int NGW) {
    LAS float* scr = (LAS float*)(F.lds + F.wave * 16384);
    bf16_t* btin = (bf16_t*)(opq(F.ws) + O_BTIN + (size_t)(l & 1) * SZ_BTIN);
    bf16_t* btbr = (bf16_t*)(opq(F.ws) + O_BTBR + (size_t)(l & 1) * SZ_SQ);
    bf16_t* bto = (bf16_t*)(opq(F.ws) + O_BTO + (size_t)(l & 1) * SZ_SQ);
    const float* w_in = ldin(8) + (size_t)l * D * INW;
    const float* w_ba = ldin(12) + (size_t)l * 512 * D; const float* w_bs = ldin(13) + (size_t)l * 256 * D; const float* w_bf = ldin(14) + (size_t)l * 256 * D;
    const float* w_o = ldin(15) + (size_t)l * D * D;
    constexpr int I_IN = 16 * (INW / 32), I_BA = 8 * 32, I_BS = 4 * 32, I_BF = 4 * 32, I_O = 16 * 32;
    constexpr int NIT = I_IN + I_BA + I_BS + I_BF + I_O;
    for (int it = gw; it < NIT; it += NGW) {
        int r = it;
        if (r < I_IN) { xpose_item<1>(w_in, INW, btin, D, 0, 0, scr, r, F.lane, (unsigned char*)(opq(F.ws) + O_BTG8) + (size_t)(l & 1) * 3072 * D); continue; } r -= I_IN;
        if (r < I_BA) { xpose_item<0>(w_ba, D, btbr, D, 0, 0, scr, r, F.lane); continue; } r -= I_BA;
        if (r < I_BS) { xpose_item<0>(w_bs, D, btbr, D, 512, 0, scr, r, F.lane); continue; } r -= I_BS;
        if (r < I_BF) { xpose_item<0>(w_bf, D, btbr, D, 768, 0, scr, r, F.lane); continue; } r -= I_BF;
        xpose_item<0>(w_o, D, bto, D, 0, 0, scr, r, F.lane);
    }
}
__device__ __forceinline__ void fold_unit(const Frame& F, const Args& a, int l, int unit4) {
    const int unit = unit4 >> 2, qt = unit4 & 3; const int g = unit >> 4, kb = unit & 15;
    LAS float* wt = (LAS float*)(F.lds);
    LAS float* ct = wt + 64 * 65;
    const float* w_in = ldin(8) + (size_t)l * D * INW;
    bf16_t* btin = (bf16_t*)(opq(F.ws) + O_BTIN + (size_t)(l & 1) * SZ_BTIN);
    __syncthreads();
    for (int i = F.tid; i < 64 * 64; i += NTHR) { const int kk = i >> 6, d = i & 63; wt[kk * 65 + d] = w_in[(size_t)(kb * 64 + kk) * INW + 1280 + g * 64 + d]; }
    if (F.tid < 64) { float s, c; sincospif((float)F.tid * (1.0f / 32.0f), &s, &c); ct[F.tid] = c; ct[64 + F.tid] = s; }
    __syncthreads();
    const int kk = F.tid & 63, rg = F.tid >> 6;
#pragma unroll 1
    for (int rr = 4 * qt; rr < 4 * qt + 4; ++rr) { const int r = rg * 16 + rr, ri = r >> 6, m = r & 63; float s = 0.f;
        for (int d = 0; d < 64; ++d) { const int idx = (m * d) & 63; const float t = ri ? -ct[64 + idx] : ct[idx]; s += wt[kk * 65 + d] * t; }
        btin[(size_t)(1280 + ri * 256 + g * 64 + m) * D + kb * 64 + kk] = (bf16_t)f2bf(s * 0.125f); }
    __syncthreads();
}
__device__ __forceinline__ void convert_expert(const Frame& F, const Args& a, int l, int gw, int NGW, const int it_lo, const int it_hi) {
    LAS float* scr = (LAS float*)(F.lds + F.wave * 16896);
    unsigned char* btgu = (unsigned char*)(opq(F.ws) + O_BTGU); unsigned char* btd = (unsigned char*)(opq(F.ws) + O_BTD);
    const float* wgp = ldin(17) + (size_t)l * NE * D * FF; const float* wup = ldin(18) + (size_t)l * NE * D * FF; const float* wdp = ldin(19) + (size_t)l * NE * FF * D;
    constexpr int I_G = (D / 128) * (FF / 32), I_D = (FF / 128) * (D / 32), I_E = 2 * I_G + I_D, NTOT = NE * I_E;
    const int lr = F.lane >> 3, lc = (F.lane & 7) * 4;
#define XP_SRC(it, src, N, k0, n0) do { const int e_ = (it) / I_E; int r_ = (it) % I_E; \
        if (r_ < I_G) { src = wgp + (size_t)e_ * D * FF; N = FF; } else if (r_ < 2 * I_G) { src = wup + (size_t)e_ * D * FF; N = FF; r_ -= I_G; } else { src = wdp + (size_t)e_ * FF * D; N = D; r_ -= 2 * I_G; } \
        const int nblk_ = N / 32; k0 = 128 * (r_ / nblk_); n0 = 32 * (r_ % nblk_); } while (0)
#define XP_LOAD(dstR, itx) do { if ((itx) < it_hi) { const float* src_; int N_, k0_, n0_; XP_SRC((itx), src_, N_, k0_, n0_); \
            _Pragma("unroll") for (int i = 0; i < 16; ++i) dstR[i] = __builtin_nontemporal_load((const f32x4*)(src_ + (size_t)(k0_ + lr + 8 * i) * N_ + n0_ + lc)); } \
        else { _Pragma("unroll") for (int i = 0; i < 16; ++i) dstR[i] = (f32x4){0.f, 0.f, 0.f, 0.f}; } } while (0)
    int it = it_lo + gw; f32x4 R[16];
    XP_LOAD(R, it);
    while (it < it_hi) {
        const int itn = it + NGW; f32x4 Rn[16];
        XP_LOAD(Rn, itn);
#pragma unroll
        for (int i = 0; i < 16; ++i) { LAS float* p = scr + (lr + 8 * i) * 33 + lc; p[0] = R[i][0]; p[1] = R[i][1]; p[2] = R[i][2]; p[3] = R[i][3]; }
        asm volatile("s_waitcnt lgkmcnt(0)" ::: "memory");
        { const int e = it / I_E; int r = it % I_E; unsigned char* dst; int ldt, nblk, mode;
          if (r < I_G) { dst = btgu + (size_t)e * 4096 * D; ldt = D; nblk = FF / 32; mode = 2; } else if (r < 2 * I_G) { dst = btgu + (size_t)e * 4096 * D; ldt = D; nblk = FF / 32; mode = 3; r -= I_G; } else { dst = btd + (size_t)e * D * FF; ldt = FF; nblk = D / 32; mode = 0; r -= 2 * I_G; }
          const int k0 = 128 * (r / nblk), n0 = 32 * (r % nblk); const int c = F.lane & 7;
#pragma unroll
          for (int j = 0; j < 4; ++j) { const int n = (F.lane >> 3) + 8 * j; const LAS float* sp = scr + (16 * c) * 33 + n;
              u32x4 o;
#pragma unroll
              for (int q = 0; q < 4; ++q) o[q] = pk4_fp8(sp[(4 * q) * 33] * 32.0f, sp[(4 * q + 1) * 33] * 32.0f, sp[(4 * q + 2) * 33] * 32.0f, sp[(4 * q + 3) * 33] * 32.0f);
              const int nn = n0 + n; const int drow = mode == 0 ? nn : (nn >> 7) * 256 + (mode == 3 ? 128 : 0) + (nn & 127);
              *(u32x4*)(dst + (size_t)drow * ldt + k0 + 16 * c) = o; } }
        asm volatile("s_waitcnt lgkmcnt(0)" ::: "memory");
#pragma unroll
        for (int i = 0; i < 16; ++i) R[i] = Rn[i];
        it = itn;
    }
#undef XP_LOAD
#undef XP_SRC
}

__device__ __forceinline__ void convert_expert_blk(const Frame& F, int l, int wg, int NWG, const int it_lo, const int it_hi) {
    LAS unsigned* T = (LAS unsigned*)(F.lds);
    unsigned char* btgu = (unsigned char*)(opq(F.ws) + O_BTGU); unsigned char* btd = (unsigned char*)(opq(F.ws) + O_BTD);
    const float* wgp = ldin(17) + (size_t)l * NE * D * FF; const float* wup = ldin(18) + (size_t)l * NE * D * FF; const float* wdp = ldin(19) + (size_t)l * NE * FF * D;
    const int ncol4 = (F.tid & 127) * 4, kgrp = F.tid >> 7;
    for (int it = it_lo + wg; it < it_hi; it += NWG) {
        const int e = it / 96; int r = it % 96; const float* src; unsigned char* dst; int N, ldt, mode;
        if (r < 32) { src = wgp + (size_t)e * D * FF; dst = btgu + (size_t)e * 4096 * D; N = FF; ldt = D; mode = 2; }
        else if (r < 64) { src = wup + (size_t)e * D * FF; dst = btgu + (size_t)e * 4096 * D; N = FF; ldt = D; mode = 3; r -= 32; }
        else { src = wdp + (size_t)e * FF * D; dst = btd + (size_t)e * D * FF; N = D; ldt = FF; mode = 0; r -= 64; }
        const int nblk = N / 512, kb = r / nblk, nb = r % nblk;
        const float* sp = src + (size_t)(kb * 128 + kgrp * 32) * N + nb * 512 + ncol4;
        f32x4 v[32];
#pragma unroll
        for (int i = 0; i < 32; ++i) v[i] = __builtin_nontemporal_load((const f32x4*)(sp + (size_t)i * N));
#pragma unroll
        for (int q = 0; q < 8; ++q) { LAS unsigned* tp = T + (kgrp * 8 + q) * 513 + ncol4;
#pragma unroll
            for (int i = 0; i < 4; ++i) tp[i] = pk4_fp8(v[4 * q][i] * 32.0f, v[4 * q + 1][i] * 32.0f, v[4 * q + 2][i] * 32.0f, v[4 * q + 3][i] * 32.0f); }
        __syncthreads();
        { const int c = F.tid & 7;
#pragma unroll
          for (int j = 0; j < 8; ++j) { const int n = (F.tid >> 3) + 64 * j; const LAS unsigned* tq = T + (4 * c) * 513 + n;
              const u32x4 o = {tq[0], tq[513], tq[2 * 513], tq[3 * 513]};
              const int nn = nb * 512 + n; const int drow = mode == 0 ? nn : (nn >> 7) * 256 + (mode == 3 ? 128 : 0) + (nn & 127);
              *(u32x4*)(dst + (size_t)drow * ldt + kb * 128 + 16 * c) = o; } }
        __syncthreads();
    }
}

constexpr int XI_PER_EXPERT = 384, XI_PER_LAYER = NE * XI_PER_EXPERT;
constexpr size_t SZ_GU8 = (size_t)NE * 4096 * D, SZ_D8 = (size_t)NE * D * FF;
__device__ __forceinline__ void convert_item128(const Frame& F, const int L, const int id) {
    LAS unsigned* T = (LAS unsigned*)(F.lds);
    unsigned char* btgu = (unsigned char*)(opq(F.ws) + O_BTGU) + (size_t)(L & 1) * SZ_GU8; unsigned char* btd = (unsigned char*)(opq(F.ws) + O_BTD) + (size_t)(L & 1) * SZ_D8;
    const float* wgp = ldin(17) + (size_t)L * NE * D * FF; const float* wup = ldin(18) + (size_t)L * NE * D * FF; const float* wdp = ldin(19) + (size_t)L * NE * FF * D;
    const int ncol4 = (F.tid & 31) * 4, kgrp = F.tid >> 5;
    const int e = id / XI_PER_EXPERT; int r = id % XI_PER_EXPERT; const float* src; unsigned char* dst; int N, ldt, mode;
    if (r < 128) { src = wgp + (size_t)e * D * FF; dst = btgu + (size_t)e * 4096 * D; N = FF; ldt = D; mode = 2; }
    else if (r < 256) { src = wup + (size_t)e * D * FF; dst = btgu + (size_t)e * 4096 * D; N = FF; ldt = D; mode = 3; r -= 128; }
    else { src = wdp + (size_t)e * FF * D; dst = btd + (size_t)e * D * FF; N = D; ldt = FF; mode = 0; r -= 256; }
    const int nblk = N / 128, kb = r / nblk, nb = r % nblk;
    const float* sp = src + (size_t)(kb * 128 + kgrp * 8) * N + nb * 128 + ncol4;
    f32x4 v[8];
#pragma unroll
    for (int i = 0; i < 8; ++i) v[i] = __builtin_nontemporal_load((const f32x4*)(sp + (size_t)i * N));
#pragma unroll
    for (int q = 0; q < 2; ++q) { LAS unsigned* tp = T + (kgrp * 2 + q) * 129 + ncol4;
#pragma unroll
        for (int i = 0; i < 4; ++i) tp[i] = pk4_fp8(v[4 * q][i] * 32.0f, v[4 * q + 1][i] * 32.0f, v[4 * q + 2][i] * 32.0f, v[4 * q + 3][i] * 32.0f); }
    __syncthreads();
    { const int c = F.tid & 7;
#pragma unroll
      for (int j = 0; j < 2; ++j) { const int n = (F.tid >> 3) + 64 * j; const LAS unsigned* tq = T + (4 * c) * 129 + n;
          const u32x4 o = {tq[0], tq[129], tq[2 * 129], tq[3 * 129]};
          const int nn = nb * 128 + n; const int drow = mode == 0 ? nn : nb * 256 + (mode == 3 ? 128 : 0) + n;
          *(u32x4*)(dst + (size_t)drow * ldt + kb * 128 + 16 * c) = o; } }
    __syncthreads();
}
constexpr int CW_XI = 12288;
__device__ __forceinline__ bool fill_one(const Frame& F, unsigned* ctl, volatile LAS unsigned* fw, const int maxL) {
    if (F.wave == 0 && lane_id() == 0) { int L = (int)fw[6], id = -1;
        while (L <= maxL && L < DEPTH) { const unsigned c = xb_add(ctl + CW_XI + 64 * L, 1u); if (c < (unsigned)XI_PER_LAYER) { id = (int)c; break; } ++L; }
        fw[6] = (unsigned)L; fw[4] = (unsigned)id; fw[5] = (unsigned)L; }
    __syncthreads();
    const int id = (int)fw[4], L = (int)fw[5];
    __syncthreads();
    if (id < 0) return false;
    convert_item128(F, L, id);
    return true;
}

__device__ __forceinline__ void xcd_barrier_fill(const XcdBarrier& b, const Frame& F, unsigned* ctl, volatile LAS unsigned* fw, const int maxL) {
    asm volatile("s_waitcnt vmcnt(0)" ::: "memory");
    __syncthreads();
    const bool t0 = (F.wave == 0) && (lane_id() == 0);
    if (t0) {
        unsigned* bar = b.bar;
        __builtin_amdgcn_s_waitcnt(0);
        unsigned nloc = b.st[0], nx = b.st[1];
        if (nloc == 0u) { xcd_barrier_complete(bar, b.x, nloc, nx); b.st[0] = nloc; b.st[1] = nx; }
        const unsigned old = xb_add(&bar[XB_XSUB(b.x)], 1u);
        const unsigned gen = old / nloc;
        if (old + 1u == (gen + 1u) * nloc) {
            __builtin_amdgcn_fence(__ATOMIC_RELEASE, "agent");
            asm volatile("s_waitcnt vmcnt(0)" ::: "memory");
            const unsigned og = xb_add(&bar[XB_TOP], 1u);
            const unsigned tg = og / nx;
            if (og + 1u == (tg + 1u) * nx) xb_add(&bar[XB_TOPGEN], 1u);
            else XB_SPIN(xb_ld(&bar[XB_TOPGEN]) == tg, bar);
            __builtin_amdgcn_fence(__ATOMIC_ACQUIRE, "agent");
            xb_add(&bar[XB_XGEN(b.x)], 1u);
            asm volatile("s_waitcnt vmcnt(0)" ::: "memory");
            fw[0] = 2u;
        } else { fw[1] = gen; fw[0] = (xb_ld(&bar[XB_XGEN(b.x)]) != gen) ? 1u : 0u; }
    }
    __syncthreads();
    unsigned polls = 0;
    while (fw[0] == 0u) {
        const bool did = fill_one(F, ctl, fw, maxL);
        if (!did) __builtin_amdgcn_s_sleep(16);
        if (t0) { unsigned* bar = b.bar; const unsigned gen = fw[1]; unsigned r = (xb_ld(&bar[XB_XGEN(b.x)]) != gen) ? 1u : 0u;
            if (!r) { if (xb_ld(&bar[XB_TMO])) r = 1u; else if (++polls > XB_SPIN_CAP) { atomicAdd(&bar[XB_TMO], 1u); r = 1u; } }
            fw[0] = r; }
        __syncthreads();
    }
    if (t0 && fw[0] == 1u) { __builtin_amdgcn_fence(__ATOMIC_ACQUIRE, "agent"); asm volatile("s_waitcnt vmcnt(0)" ::: "memory"); }
    __syncthreads();
}

__device__ __forceinline__ void modvec_units(const Frame& F, const Args& a) {
    LAS float* sv = (LAS float*)(F.lds);
    LAS float* part = sv + 3 * 1024;
    __syncthreads();
    for (int i = F.tid; i < 3 * 1024; i += NTHR) { const float x = i < 2048 ? ldin(1)[i] : ldin(3)[i - 2048]; sv[i] = x / (1.0f + __expf(-x)); }
    __syncthreads();
    float* modv = (float*)(opq(F.ws) + O_MODV);
    const int c4 = (F.tid & 7) * 4, kg = F.tid >> 3;
    for (int unit = F.blk; unit < DEPTH * 192; unit += F.G) {
        const int l = unit / 192, cb = unit % 192;
        const float* w = ldin(4) + (size_t)l * D * NMOD + (size_t)(kg * 16) * NMOD + cb * 32 + c4;
        f32x4 wv[16];
#pragma unroll
        for (int i = 0; i < 16; ++i) wv[i] = *(const f32x4*)(w + (size_t)i * NMOD);
        f32x4 s0 = {0.f, 0.f, 0.f, 0.f}, s1 = s0, s2 = s0;
#pragma unroll
        for (int i = 0; i < 16; ++i) { const int k = kg * 16 + i; s0 += wv[i] * sv[k]; s1 += wv[i] * sv[1024 + k]; s2 += wv[i] * sv[2048 + k]; }
        *(LAS f32x4*)(part + (kg * 3 + 0) * 32 + c4) = s0; *(LAS f32x4*)(part + (kg * 3 + 1) * 32 + c4) = s1; *(LAS f32x4*)(part + (kg * 3 + 2) * 32 + c4) = s2;
        __syncthreads();
        if (F.tid < 96) { const int v = F.tid >> 5, jj = F.tid & 31; float s = ldin(5)[(size_t)l * NMOD + cb * 32 + jj];
#pragma unroll 8
            for (int q = 0; q < 64; ++q) s += part[(q * 3 + v) * 32 + jj];
            modv[((size_t)l * 3 + v) * NMOD + cb * 32 + jj] = s; }
        __syncthreads();
    }
}
__device__ __forceinline__ void tables(const Frame& F) {
    const size_t gt = (size_t)F.blk * NTHR + F.tid, GT = (size_t)F.G * NTHR;
    float* rc = (float*)(opq(F.ws) + O_ROPEC); float* rs = (float*)(opq(F.ws) + O_ROPES);
    for (size_t i = gt; i < (size_t)SEQ * 32; i += GT) { const int n = (int)(i >> 5), p = (int)(i & 31); const int row = n >> 6, col = n & 63;
        const float inv = powf(10000.0f, -(float)(p & 15) * (1.0f / 16.0f)); const float ang = (float)(p < 16 ? row : col) * inv;
        rc[i] = cosf(ang); rs[i] = sinf(ang); }
    float* twc = (float*)(opq(F.ws) + O_TWC); float* tws = (float*)(opq(F.ws) + O_TWS);
    for (size_t i = gt; i < 128 * 128; i += GT) { const int k1 = (int)(i >> 7), n2 = (int)(i & 127); float s, c; sincospif((float)((k1 * n2) & 16383) * (1.0f / 8192.0f), &s, &c); twc[i] = c; tws[i] = s; }
    bf16_t* TA = (bf16_t*)(opq(F.ws) + O_TA); bf16_t* TC = (bf16_t*)(opq(F.ws) + O_TC); bf16_t* TX = (bf16_t*)(opq(F.ws) + O_TX);
    const float sc = 0.08838834764831845f;
    for (size_t i = gt; i < 256 * 256; i += GT) { const int r = (int)(i >> 8), k = (int)(i & 255); const int ri = r >> 7, k1 = r & 127, rip = k >> 7, n1 = k & 127;
        float s, c; sincospif((float)((k1 * n1) & 127) * (1.0f / 64.0f), &s, &c);
        const float v = (ri == rip) ? c : (ri == 0 ? s : -s);
        TA[i] = (bf16_t)f2bf(v * sc);
        TC[i] = (bf16_t)f2bf((rip == 0 ? c : s) * sc); }
    for (size_t i = gt; i < 256 * 512; i += GT) { const int k = (int)(i >> 9), kk = (int)(i & 511); const int rip = kk >> 8, n = kk & 255;
        float s, c; sincospif((float)((k * n) & 255) * (1.0f / 128.0f), &s, &c); TX[i] = (bf16_t)f2bf((rip == 0 ? c : s) * 0.0625f); }
}

__device__ __forceinline__ void norm_mod_store(const f32x4 (&v)[4], const float* gain, const float* sh, const float* sc, bf16_t* orow, unsigned char* orow8, int lane) {
    float ss = 0.f;
#pragma unroll
    for (int j = 0; j < 4; ++j) ss += (v[j][0] * v[j][0] + v[j][1] * v[j][1]) + (v[j][2] * v[j][2] + v[j][3] * v[j][3]);
    const float r = __builtin_amdgcn_rsqf(wave_sum(ss) * (1.0f / D) + EPS);
#pragma unroll
    for (int j = 0; j < 4; ++j) { const f32x4 g = ((const f32x4*)gain)[lane + 64 * j], s1 = ((const f32x4*)sc)[lane + 64 * j], s0 = ((const f32x4*)sh)[lane + 64 * j];
        const f32x4 y = v[j] * r * g * (s1 + 1.0f) + s0;
        ((u32x2*)orow)[lane + 64 * j] = (u32x2){pk2(y[0], y[1]), pk2(y[2], y[3])};
        ((unsigned*)orow8)[lane + 64 * j] = pk4_fp8(y[0], y[1], y[2], y[3]); }
}
__device__ __forceinline__ int modsel(int row) { return row < SEQ ? 0 : row < NLAT ? 1 : 2; }
__device__ __forceinline__ void phase_norm1_in(const Frame& F, const Args& a) {
    const int gw = F.blk * NWAVES + F.wave, NGW = F.G * NWAVES;
    const float* modv = (const float*)(opq(F.ws) + O_MODV); bf16_t* HB = (bf16_t*)(opq(F.ws) + O_HB);
    const float* xlat = ldin(0); const float* xctx = ldin(2) - (size_t)NLAT * D;
    f32x4 vn[4];
    if (gw < NR) { const float* xr = (gw < NLAT ? xlat : xctx) + (size_t)gw * D;
#pragma unroll
        for (int j = 0; j < 4; ++j) vn[j] = ((const f32x4*)xr)[F.lane + 64 * j]; }
    for (int row = gw; row < NR; row += NGW) {
        f32x4 v[4];
#pragma unroll
        for (int j = 0; j < 4; ++j) v[j] = vn[j];
        if (row + NGW < NR) { const int rn = row + NGW; const float* xr = (rn < NLAT ? xlat : xctx) + (size_t)rn * D;
#pragma unroll
            for (int j = 0; j < 4; ++j) vn[j] = ((const f32x4*)xr)[F.lane + 64 * j]; }
        const float* mv = modv + (size_t)modsel(row) * NMOD;
        norm_mod_store(v, ldin(6), mv, mv + D, HB + (size_t)row * D, (unsigned char*)(opq(F.ws) + O_HB8) + (size_t)row * D, F.lane);
    }
}
__device__ __forceinline__ void phase_norm2(const Frame& F, const Args& a, int l, const int rowlo, const int rowhi, const int gw, const int NGW) {
    LAS float* wr = (LAS float*)(F.lds);
    __syncthreads();
    { const float* w = ldin(16) + (size_t)l * D * NE; for (int i = F.tid; i < D * NE / 4; i += NTHR) { const f32x4 w4 = ((const f32x4*)w)[i]; const int k = i >> 2, e0 = (i & 3) * 4;
        wr[(e0 + 0) * D + k] = w4[0]; wr[(e0 + 1) * D + k] = w4[1]; wr[(e0 + 2) * D + k] = w4[2]; wr[(e0 + 3) * D + k] = w4[3]; } }
    __syncthreads();
    const float* modv = (const float*)(opq(F.ws) + O_MODV) + (size_t)l * 3 * NMOD; const float* gain = ldin(7) + (size_t)l * D;
    const float* XW = (const float*)(opq(F.ws) + O_XW); unsigned char* HB8 = (unsigned char*)(opq(F.ws) + O_HB8);
    float* affl = (float*)(opq(F.ws) + O_AFFL); float* affc = (float*)(opq(F.ws) + O_AFFC);
    const bf16_t* XWb = (const bf16_t*)(opq(F.ws) + O_XW);
    u32x2 vn[4];
    { const int row0 = rowlo + gw; if (row0 < rowhi) {
#pragma unroll
        for (int j = 0; j < 4; ++j) vn[j] = ((const u32x2*)(XWb + (size_t)row0 * D))[F.lane + 64 * j]; } }
    for (int row = rowlo + gw; row < rowhi; row += NGW) {
        const float* mv = modv + (size_t)modsel(row) * NMOD;
        f32x4 v[4]; float ss = 0.f;
#pragma unroll
        for (int j = 0; j < 4; ++j) { v[j] = (f32x4){bflo(vn[j][0]), bfhi(vn[j][0]), bflo(vn[j][1]), bfhi(vn[j][1])}; ss += (v[j][0] * v[j][0] + v[j][1] * v[j][1]) + (v[j][2] * v[j][2] + v[j][3] * v[j][3]); }
        if (row + NGW < rowhi) {
#pragma unroll
            for (int j = 0; j < 4; ++j) vn[j] = ((const u32x2*)(XWb + (size_t)(row + NGW) * D))[F.lane + 64 * j]; }
        const float r = __builtin_amdgcn_rsqf(wave_sum(ss) * (1.0f / D) + EPS);
        float lg[16];
#pragma unroll
        for (int e = 0; e < 16; ++e) lg[e] = 0.f;
#pragma unroll
        for (int j = 0; j < 4; ++j) { __builtin_amdgcn_sched_barrier(0);
            const f32x4 g = ((const f32x4*)gain)[F.lane + 64 * j], s1 = ((const f32x4*)(mv + 4 * D))[F.lane + 64 * j], s0 = ((const f32x4*)(mv + 3 * D))[F.lane + 64 * j];
            const f32x4 h = v[j] * r * g * (s1 + 1.0f) + s0;
            ((unsigned*)(HB8 + (size_t)row * D))[F.lane + 64 * j] = pk4_fp8(h[0], h[1], h[2], h[3]);
#pragma unroll
            for (int e = 0; e < 16; ++e) { if ((e & 7) == 0) __builtin_amdgcn_sched_barrier(0);
                const f32x4 w4 = ((const LAS f32x4*)(wr + e * D))[F.lane + 64 * j]; lg[e] += (h[0] * w4[0] + h[1] * w4[1]) + (h[2] * w4[2] + h[3] * w4[3]); } }
        const bool b5 = (F.lane & 32) != 0, b4 = (F.lane & 16) != 0, b3 = (F.lane & 8) != 0, b2 = (F.lane & 4) != 0;
        float a8[8], a4[4], a2[2], a1;
#pragma unroll
        for (int i = 0; i < 8; ++i) { const float keep = b5 ? lg[i + 8] : lg[i], send = b5 ? lg[i] : lg[i + 8]; a8[i] = keep + __shfl_xor(send, 32); }
#pragma unroll
        for (int i = 0; i < 4; ++i) { const float keep = b4 ? a8[i + 4] : a8[i], send = b4 ? a8[i] : a8[i + 4]; a4[i] = keep + __shfl_xor(send, 16); }
#pragma unroll
        for (int i = 0; i < 2; ++i) { const float keep = b3 ? a4[i + 2] : a4[i], send = b3 ? a4[i] : a4[i + 2]; a2[i] = keep + __shfl_xor(send, 8); }
        { const float keep = b2 ? a2[1] : a2[0], send = b2 ? a2[0] : a2[1]; a1 = keep + __shfl_xor(send, 4); }
        a1 += __shfl_xor(a1, 2); a1 += __shfl_xor(a1, 1);
        float mx = a1;
        mx = fmaxf(mx, __shfl_xor(mx, 32)); mx = fmaxf(mx, __shfl_xor(mx, 16)); mx = fmaxf(mx, __shfl_xor(mx, 8)); mx = fmaxf(mx, __shfl_xor(mx, 4));
        const float ex = __expf(a1 - mx);
        float den = ex; den += __shfl_xor(den, 32); den += __shfl_xor(den, 16); den += __shfl_xor(den, 8); den += __shfl_xor(den, 4);
        const float mine = ex / den; const int e = (F.lane >> 2) & 15;
        if ((F.lane & 3) == 0) { if (row < NLAT) affl[((size_t)(row >> 14) * NE + e) * SEQ + (row & (SEQ - 1))] = mine;
                                 else { const int rc = row - NLAT; affc[((size_t)(rc >> 8) * NE + e) * LCTX + (rc & 255)] = mine; } }
    }
}
__device__ __forceinline__ void phase_combine(const Frame& F, const Args& a, int l) {
    const int gw = F.blk * NWAVES + F.wave, NGW = F.G * NWAVES;
    const float* modv = (const float*)(opq(F.ws) + O_MODV) + (size_t)l * 3 * NMOD;
    float* XW = (float*)(opq(F.ws) + O_XW); bf16_t* HB = (bf16_t*)(opq(F.ws) + O_HB);
    const int* slotof = (const int*)(opq(F.ws) + O_SLOTOF); const float* gsel = (const float*)(opq(F.ws) + O_GSEL); const bf16_t* YB = (const bf16_t*)(opq(F.ws) + O_YB);
    const bool last = (l == DEPTH - 1);
    const int rr = F.lane >> 4, li = F.lane & 15;
    const int ngrp = (last ? NLAT : NR) / 4;
    for (int gi = gw; gi < ngrp; gi += NGW) {
        const int row = gi * 4 + rr;
        const float* mv = modv + (size_t)modsel(gi * 4) * NMOD;
        bf16_t* xr = (bf16_t*)XW + (size_t)row * D;
        int myslot = slotof[(size_t)li * NR + row]; float myg = 0.f; if (myslot >= 0) myg = gsel[li * EROWS + myslot];
        f32x4 v[16], accv[16];
#pragma unroll
        for (int j = 0; j < 8; ++j) { const u32x4 xw = *(const u32x4*)(xr + 8 * (li + 16 * j)); v[2 * j] = (f32x4){bflo(xw[0]), bfhi(xw[0]), bflo(xw[1]), bfhi(xw[1])}; v[2 * j + 1] = (f32x4){bflo(xw[2]), bfhi(xw[2]), bflo(xw[3]), bfhi(xw[3])}; accv[2 * j] = (f32x4){0.f, 0.f, 0.f, 0.f}; accv[2 * j + 1] = (f32x4){0.f, 0.f, 0.f, 0.f}; }
        const unsigned long long bal = __ballot(myslot >= 0);
        unsigned m16 = (unsigned)(bal >> (16 * rr)) & 0xffffu;
        int nmax = __builtin_popcount((unsigned)(bal & 0xffffull)); { const int n1 = __builtin_popcount((unsigned)((bal >> 16) & 0xffffull)), n2 = __builtin_popcount((unsigned)((bal >> 32) & 0xffffull)), n3 = __builtin_popcount((unsigned)((bal >> 48) & 0xffffull));
            nmax = nmax > n1 ? nmax : n1; nmax = nmax > n2 ? nmax : n2; nmax = nmax > n3 ? nmax : n3; }
#define CB_FETCH(W, G, A) do { A = m16 != 0u; const int e_ = A ? (__builtin_ffs((int)m16) - 1) : 0; m16 &= m16 - 1u; \
            const int s_ = __shfl(myslot, 16 * rr + e_); const float gv_ = __shfl(myg, 16 * rr + e_); G = gv_ * 0.125f; \
            if (A) { const u32x2* yr_ = (const u32x2*)((const unsigned char*)YB + ((size_t)e_ * EROWS + s_) * D);        \
                _Pragma("unroll") for (int j = 0; j < 8; ++j) W[j] = yr_[li + 16 * j]; } } while (0)
        u32x2 wc_[8]; float gcur = 0.f; bool acur = false;
        if (nmax > 0) CB_FETCH(wc_, gcur, acur);
#pragma unroll 1
        for (int i = 0; i < nmax; ++i) {
            u32x2 wn_[8]; float gnx = 0.f; bool anx = false;
#pragma unroll
            for (int j = 0; j < 8; ++j) wn_[j] = (u32x2){0u, 0u};
            if (i + 1 < nmax) CB_FETCH(wn_, gnx, anx);
            if (acur) {
#pragma unroll
                for (int j = 0; j < 8; ++j) { const f32x2 a0 = __builtin_amdgcn_cvt_pk_f32_fp8((int)wc_[j][0], false), a1 = __builtin_amdgcn_cvt_pk_f32_fp8((int)wc_[j][0], true), b0 = __builtin_amdgcn_cvt_pk_f32_fp8((int)wc_[j][1], false), b1 = __builtin_amdgcn_cvt_pk_f32_fp8((int)wc_[j][1], true);
                    accv[2 * j] += (f32x4){a0[0], a0[1], a1[0], a1[1]} * gcur; accv[2 * j + 1] += (f32x4){b0[0], b0[1], b1[0], b1[1]} * gcur; } }
#pragma unroll
            for (int j = 0; j < 8; ++j) wc_[j] = wn_[j];
            gcur = gnx; acur = anx;
        }
#undef CB_FETCH
        float ss = 0.f;
#pragma unroll
        for (int j = 0; j < 8; ++j) {
#pragma unroll
            for (int h = 0; h < 2; ++h) { const f32x4 gt = *(const f32x4*)(mv + 5 * D + 8 * (li + 16 * j) + 4 * h); f32x4& x = v[2 * j + h]; x += gt * accv[2 * j + h];
                ss += (x[0] * x[0] + x[1] * x[1]) + (x[2] * x[2] + x[3] * x[3]); } }
        ss += __shfl_xor(ss, 1); ss += __shfl_xor(ss, 2); ss += __shfl_xor(ss, 4); ss += __shfl_xor(ss, 8);
        const float r = __builtin_amdgcn_rsqf(ss * (1.0f / D) + EPS);
        if (!last) {
            const float* mvn = mv + (size_t)3 * NMOD;
            const float* gain = ldin(6) + (size_t)(l + 1) * D; bf16_t* orow = HB + (size_t)row * D; unsigned char* orow8 = (unsigned char*)(opq(F.ws) + O_HB8) + (size_t)row * D;
#pragma unroll
            for (int j = 0; j < 8; ++j) { const int c0 = 8 * (li + 16 * j);
                *(u32x4*)(xr + c0) = pack8(v[2 * j], v[2 * j + 1]);
                f32x4 y[2];
#pragma unroll
                for (int h = 0; h < 2; ++h) { const f32x4 g = *(const f32x4*)(gain + c0 + 4 * h), s1 = *(const f32x4*)(mvn + D + c0 + 4 * h), s0 = *(const f32x4*)(mvn + c0 + 4 * h); y[h] = v[2 * j + h] * r * g * (s1 + 1.0f) + s0; }
                *(u32x4*)(orow + c0) = pack8(y[0], y[1]);
                *(u32x2*)(orow8 + c0) = (u32x2){pk4_fp8(y[0][0], y[0][1], y[0][2], y[0][3]), pk4_fp8(y[1][0], y[1][1], y[1][2], y[1][3])}; }
        } else {
            const float* gf = ldin(20); float* orow = ldout() + (size_t)row * D;
#pragma unroll
            for (int j = 0; j < 8; ++j) { const int c0 = 8 * (li + 16 * j);
                *(f32x4*)(orow + c0) = v[2 * j] * r * *(const f32x4*)(gf + c0); *(f32x4*)(orow + c0 + 4) = v[2 * j + 1] * r * *(const f32x4*)(gf + c0 + 4); }
        }
    }
}
__device__ __forceinline__ void phase_gather(const Frame& F, const bool latonly) {
    const int gw = F.blk * NWAVES + F.wave, NGW = F.G * NWAVES;
    const int* rowsel = (const int*)(opq(F.ws) + O_ROWSEL); const unsigned char* HB8 = (const unsigned char*)(opq(F.ws) + O_HB8); unsigned char* XE = (unsigned char*)(opq(F.ws) + O_XE);
    for (int er0 = gw; er0 < NEROWS; er0 += 4 * NGW) { int src[4]; bool ok[4]; u32x4 v[4];
#pragma unroll
        for (int q = 0; q < 4; ++q) { const int er = er0 + q * NGW; ok[q] = er < NEROWS && !(latonly && (er % EROWS) >= 2 * CAP); src[q] = ok[q] ? rowsel[er] : 0; }
#pragma unroll
        for (int q = 0; q < 4; ++q) v[q] = ((const u32x4*)(HB8 + (size_t)src[q] * D))[F.lane];
#pragma unroll
        for (int q = 0; q < 4; ++q) if (ok[q]) ((u32x4*)(XE + (size_t)(er0 + q * NGW) * D))[F.lane] = v[q]; }
}

__device__ __forceinline__ unsigned block_excl_scan(unsigned v, LAS unsigned* wsum, int tid, int lane, int wave, unsigned& total) {
    unsigned inc = v;
#pragma unroll
    for (int o = 1; o < 64; o <<= 1) { const unsigned t = __shfl_up(inc, o); if (lane >= o) inc += t; }
    __syncthreads();
    if (lane == 63) wsum[wave] = inc;
    __syncthreads();
    unsigned base = 0, tot = 0;
#pragma unroll
    for (int w = 0; w < NWAVES; ++w) { const unsigned s = wsum[w]; if (w < wave) base += s; tot += s; }
    total = tot;
    return base + inc - v;
}
__device__ __forceinline__ void select_unit(const Frame& F, int unit) {
    LAS unsigned* hist = (LAS unsigned*)(F.lds);
    LAS unsigned* sh = hist + 256;
    LAS unsigned* wsum = sh + 8;
    LAS int* srow = (LAS int*)(wsum + 8);
    const bool isctx = unit >= 32; const int ub = isctx ? unit - 32 : unit; const int b = ub >> 4, e = ub & 15;
    const int n = isctx ? LCTX : SEQ, k = isctx ? CAPC : CAP;
    const float* src = isctx ? (const float*)(opq(F.ws) + O_AFFC) + (size_t)(b * NE + e) * LCTX : (const float*)(opq(F.ws) + O_AFFL) + (size_t)(b * NE + e) * SEQ;
    const int rowbase = isctx ? NLAT + b * LCTX : b * SEQ, slotbase = isctx ? 2 * CAP + b * CAPC : b * CAP;
    int* rowsel = (int*)(opq(F.ws) + O_ROWSEL) + e * EROWS; float* gsel = (float*)(opq(F.ws) + O_GSEL) + e * EROWS; int* slotof = (int*)(opq(F.ws) + O_SLOTOF) + (size_t)e * NR;
    const bool act = F.tid * 32 < n;
    unsigned key[32];
#pragma unroll
    for (int q = 0; q < 8; ++q) { u32x4 w = {0u, 0u, 0u, 0u}; if (act) w = ((const u32x4*)(src + F.tid * 32))[q]; key[4 * q] = w[0]; key[4 * q + 1] = w[1]; key[4 * q + 2] = w[2]; key[4 * q + 3] = w[3]; }
    unsigned prefix = 0, kk = (unsigned)k;
#pragma unroll 1
    for (int pass = 3; pass >= 0; --pass) {
        const int shift = 8 * pass;
        __syncthreads();
        if (F.tid < 256) hist[F.tid] = 0u;
        __syncthreads();
        if (act) {
#pragma unroll
            for (int i = 0; i < 32; ++i) { const bool m = (pass == 3) ? true : ((key[i] >> (shift + 8)) == prefix); if (m) __hip_atomic_fetch_add(&hist[(key[i] >> shift) & 255u], 1u, __ATOMIC_RELAXED, __HIP_MEMORY_SCOPE_WORKGROUP); }
        }
        __syncthreads();
        if (F.wave == 0) {
            const unsigned h0 = hist[4 * F.lane], h1 = hist[4 * F.lane + 1], h2 = hist[4 * F.lane + 2], h3 = hist[4 * F.lane + 3];
            const unsigned s = h0 + h1 + h2 + h3; unsigned suf = s;
#pragma unroll
            for (int o = 1; o < 64; o <<= 1) { const unsigned t = __shfl_down(suf, o); if (F.lane + o < 64) suf += t; }
            const unsigned above = suf - s;
            if (above < kk && kk <= suf) { unsigned c = above; int d;
                if (c + h3 >= kk) d = 3; else { c += h3; if (c + h2 >= kk) d = 2; else { c += h2; if (c + h1 >= kk) d = 1; else { c += h1; d = 0; } } }
                sh[0] = (prefix << 8) | (unsigned)(4 * F.lane + d); sh[1] = kk - c; }
        }
        __syncthreads();
        prefix = sh[0]; kk = sh[1];
    }
    const unsigned T = prefix;
    unsigned ceq = 0;
#pragma unroll
    for (int i = 0; i < 32; ++i) ceq += (act && key[i] == T) ? 1u : 0u;
    unsigned tot;
    unsigned eqb = block_excl_scan(ceq, wsum, F.tid, F.lane, F.wave, tot);
    unsigned selmask = 0, csel = 0;
#pragma unroll
    for (int i = 0; i < 32; ++i) { bool s = false; if (act) { if (key[i] > T) s = true; else if (key[i] == T) { s = eqb < kk; ++eqb; } } if (s) { selmask |= 1u << i; ++csel; } }
    unsigned slot = block_excl_scan(csel, wsum, F.tid, F.lane, F.wave, tot);
    if (act) {
#pragma unroll
        for (int i = 0; i < 32; ++i) { const int row = rowbase + F.tid * 32 + i;
            if (selmask & (1u << i)) { const int sl = slotbase + (int)slot; if (isctx) srow[slot] = row; ++slot; slotof[row] = sl; rowsel[sl] = row; gsel[sl] = __builtin_bit_cast(float, key[i]); }
            else slotof[row] = -1; }
    }
    if (isctx && b == 1 && F.tid < EROWS - (2 * CAP + 2 * CAPC)) { rowsel[2 * CAP + 2 * CAPC + F.tid] = 0; gsel[2 * CAP + 2 * CAPC + F.tid] = 0.f; }
    __syncthreads();
    if (isctx) {
        const unsigned char* HB8 = (const unsigned char*)(opq(F.ws) + O_HB8); unsigned char* XE = (unsigned char*)(opq(F.ws) + O_XE);
        for (int si = F.wave; si < CAPC; si += NWAVES) { const int src = srow[si];
            ((u32x4*)(XE + ((size_t)e * EROWS + slotbase + si) * D))[F.lane] = ((const u32x4*)(HB8 + (size_t)src * D))[F.lane]; }
        __syncthreads();
    }
}

__device__ __forceinline__ int crow(int r, int hi) { return (r & 3) + 8 * (r >> 2) + 4 * hi; }
__device__ __forceinline__ void attn_unit(const Frame& F, int unit, const float* sinkv  ) {
    constexpr int KP = 144;
    constexpr int BUFB = 2 * 64 * KP;
    const bf16_t* QB = (const bf16_t*)(opq(F.ws) + O_QB); const bf16_t* KVB = (const bf16_t*)(opq(F.ws) + O_KVB); bf16_t* CAT = (bf16_t*)(opq(F.ws) + O_CAT);
    const bool isctx = unit >= 512; int b, qb, kvh;
    if (!isctx) { b = unit >> 8; qb = (unit >> 1) & 127; kvh = unit & 1; } else { const int uu = unit - 512; b = uu >> 2; qb = (uu >> 1) & 1; kvh = uu & 1; }
    const int qrow0 = isctx ? NLAT + b * LCTX + qb * 128 : b * SEQ + qb * 128;
    const int lane = F.lane, r32 = lane & 31, hi = lane >> 5, g = F.wave >> 1, qh = F.wave & 1, head = kvh * 4 + g;
    int lt0 = 0, nloc = 0;
    if (!isctx) { lt0 = (qb == 0) ? 2 : 0; const int lt1 = (qb == 127) ? 4 : 6; nloc = lt1 - lt0; }
    const int ntile = nloc + 4;
    const int ctxrow0 = NLAT + b * LCTX;
    bf16x8 qr[2][4];
#pragma unroll
    for (int qk = 0; qk < 2; ++qk)
#pragma unroll
        for (int d0 = 0; d0 < 4; ++d0) qr[qk][d0] = *(const bf16x8*)(QB + (size_t)(qrow0 + qh * 64 + qk * 32 + r32) * 512 + head * 64 + d0 * 16 + hi * 8);
    const float sink2 = sinkv[head] * LOG2E;
    float mrun[2] = {sink2, sink2}, lrun[2] = {hi == 0 ? 1.f : 0.f, hi == 0 ? 1.f : 0.f};
    f32x16 o[2][2];
#pragma unroll
    for (int qk = 0; qk < 2; ++qk)
#pragma unroll
        for (int db = 0; db < 2; ++db)
#pragma unroll
            for (int r = 0; r < 16; ++r) o[qk][db][r] = 0.f;
    const int kr = F.tid >> 3, ch = F.tid & 7;
    u32x4 kreg, vreg;
#define ATT_TROW(t) ((t) < nloc ? (b * SEQ + qb * 128 - 128 + 64 * (lt0 + (t))) : (ctxrow0 + 64 * ((t) - nloc)))
#define ATT_LOAD(t) do { const bf16_t* p_ = KVB + (size_t)(ATT_TROW(t) + kr) * 256 + kvh * 64 + ch * 8; kreg = *(const u32x4*)p_; vreg = *(const u32x4*)(p_ + 128); } while (0)
#define ATT_STORE(buf) do { LAS unsigned char* kb_ = F.lds + (buf) * BUFB; *(LAS u32x4*)(kb_ + kr * KP + ch * 16) = kreg; LAS unsigned char* vb_ = kb_ + 64 * KP + kr * 2; \
        _Pragma("unroll") for (int e_ = 0; e_ < 4; ++e_) { *(LAS unsigned short*)(vb_ + (ch * 8 + 2 * e_) * KP) = (unsigned short)(vreg[e_] & 0xffffu); *(LAS unsigned short*)(vb_ + (ch * 8 + 2 * e_ + 1) * KP) = (unsigned short)(vreg[e_] >> 16); } } while (0)
    __syncthreads();
    ATT_LOAD(0); ATT_STORE(0);
    __syncthreads();
#pragma unroll 1
    for (int t = 0; t < ntile; ++t) {
        const int buf = t & 1;
        if (t + 1 < ntile) ATT_LOAD(t + 1);
        const bool loc = t < nloc; const int kp0 = loc ? -128 + 64 * (lt0 + t) : 0;
        const LAS unsigned char* Kb = F.lds + buf * BUFB; const LAS unsigned char* Vb = Kb + 64 * KP;
        bool rel[2] = {true, true}, needmask[2] = {false, false};
        if (loc) {
#pragma unroll
            for (int kh = 0; kh < 2; ++kh) { const int k0 = kp0 + 32 * kh, qmin = qh * 64, qmax = qh * 64 + 63;
                rel[kh] = !((k0 - qmax > 128) || (qmin - (k0 + 31) > 128)); needmask[kh] = (k0 + 31 - qmin > 128) || (qmax - k0 > 128); } }
        if (rel[0] || rel[1]) {
            f32x16 p[2][2];
#pragma unroll
            for (int kh = 0; kh < 2; ++kh) if (rel[kh]) {
                bf16x8 kf[4];
#pragma unroll
                for (int d0 = 0; d0 < 4; ++d0) kf[d0] = *(const LAS bf16x8*)(Kb + (kh * 32 + r32) * KP + (d0 * 16 + hi * 8) * 2);
#pragma unroll
                for (int qk = 0; qk < 2; ++qk) {
                    f32x16 sacc;
#pragma unroll
                    for (int r = 0; r < 16; ++r) sacc[r] = 0.f;
#pragma unroll
                    for (int d0 = 0; d0 < 4; ++d0) sacc = __builtin_amdgcn_mfma_f32_32x32x16_bf16(kf[d0], qr[qk][d0], sacc, 0, 0, 0);
                    p[kh][qk] = sacc; } }
#pragma unroll
            for (int qk = 0; qk < 2; ++qk) {
                const int qp = qh * 64 + qk * 32 + r32;
                float mx = -1.0e30f;
#pragma unroll
                for (int kh = 0; kh < 2; ++kh) if (rel[kh]) {
                    if (needmask[kh]) {
#pragma unroll
                        for (int r = 0; r < 16; ++r) { const int dlt = kp0 + kh * 32 + crow(r, hi) - qp; if (dlt > 128 || dlt < -128) p[kh][qk][r] = -1.0e30f; } }
#pragma unroll
                    for (int r = 0; r < 16; ++r) mx = fmaxf(mx, p[kh][qk][r]); }
                mx = fmaxf(mx, __shfl_xor(mx, 32));
                const float mnew = fmaxf(mrun[qk], mx), alpha = __builtin_amdgcn_exp2f(mrun[qk] - mnew);
                mrun[qk] = mnew;
                float ls = 0.f;
#pragma unroll
                for (int kh = 0; kh < 2; ++kh) if (rel[kh]) {
#pragma unroll
                    for (int r = 0; r < 16; ++r) { const float e = __builtin_amdgcn_exp2f(p[kh][qk][r] - mnew); p[kh][qk][r] = e; ls += e; } }
                lrun[qk] = lrun[qk] * alpha + ls;
                if (!__all(alpha == 1.0f)) {
#pragma unroll
                    for (int db = 0; db < 2; ++db)
#pragma unroll
                        for (int r = 0; r < 16; ++r) o[qk][db][r] *= alpha; }
            }
#pragma unroll
            for (int kh = 0; kh < 2; ++kh) if (rel[kh]) {
#pragma unroll
                for (int ks = 0; ks < 2; ++ks) {
                    bf16x8 pf[2];
#pragma unroll
                    for (int qk = 0; qk < 2; ++qk) { const u32x4 w = {pk2(p[kh][qk][8 * ks], p[kh][qk][8 * ks + 1]), pk2(p[kh][qk][8 * ks + 2], p[kh][qk][8 * ks + 3]), pk2(p[kh][qk][8 * ks + 4], p[kh][qk][8 * ks + 5]), pk2(p[kh][qk][8 * ks + 6], p[kh][qk][8 * ks + 7])};
                        pf[qk] = __builtin_bit_cast(bf16x8, w); }
                    const int kvb = kh * 32 + ks * 16 + 4 * hi;
#pragma unroll
                    for (int db = 0; db < 2; ++db) {
                        const LAS unsigned char* vp = Vb + (db * 32 + r32) * KP + kvb * 2;
                        const u32x2 lo = *(const LAS u32x2*)(vp), hi8 = *(const LAS u32x2*)(vp + 16);
                        const u32x4 vw = {lo[0], lo[1], hi8[0], hi8[1]};
                        const bf16x8 vf = __builtin_bit_cast(bf16x8, vw);
#pragma unroll
                        for (int qk = 0; qk < 2; ++qk) o[qk][db] = __builtin_amdgcn_mfma_f32_32x32x16_bf16(vf, pf[qk], o[qk][db], 0, 0, 0);
                    }
                }
            }
        }
        if (t + 1 < ntile) ATT_STORE(buf ^ 1);
        __syncthreads();
    }
#undef ATT_TROW
#undef ATT_LOAD
#undef ATT_STORE
#pragma unroll
    for (int qk = 0; qk < 2; ++qk) {
        const float lt = lrun[qk] + __shfl_xor(lrun[qk], 32); const float inv = 1.0f / lt;
        bf16_t* orow = CAT + (size_t)(qrow0 + qh * 64 + qk * 32 + r32) * D + head * 64;
#pragma unroll
        for (int db = 0; db < 2; ++db)
#pragma unroll
            for (int jg = 0; jg < 4; ++jg) { const int d = db * 32 + 8 * jg + 4 * hi;
                *(u32x2*)(orow + d) = (u32x2){pk2(o[qk][db][4 * jg] * inv, o[qk][db][4 * jg + 1] * inv), pk2(o[qk][db][4 * jg + 2] * inv, o[qk][db][4 * jg + 3] * inv)}; }
    }
}

__device__ __forceinline__ void sgu_unit(const Frame& F, const Args& a, int l, int chunk) {
    const bf16_t* VST = (const bf16_t*)(opq(F.ws) + O_VST); const bf16_t* UB = (const bf16_t*)(opq(F.ws) + O_UB); bf16_t* CAT = (bf16_t*)(opq(F.ws) + O_CAT);
    const int lane = F.lane, r32 = lane & 31, hi = lane >> 5, g = F.wave >> 1, ih = F.wave & 1; const int R0 = chunk * 128;
    const float* ws = ldin(10) + ((size_t)l * 4 + g) * 128 * 128; const float* bs = ldin(11) + ((size_t)l * 4 + g) * 128;
    f32x16 acc[2][2];
#pragma unroll
    for (int mb = 0; mb < 2; ++mb)
#pragma unroll
        for (int nb = 0; nb < 2; ++nb)
#pragma unroll
            for (int r = 0; r < 16; ++r) acc[mb][nb][r] = 0.f;
#pragma unroll 2
    for (int ks = 0; ks < 8; ++ks) {
        bf16x8 af[2], bfr[2];
#pragma unroll
        for (int mb = 0; mb < 2; ++mb) af[mb] = *(const bf16x8*)(VST + (size_t)(g * 64 + mb * 32 + r32) * NR + R0 + ks * 16 + hi * 8);
#pragma unroll
        for (int nb = 0; nb < 2; ++nb) { const float* wp = ws + (size_t)(ih * 64 + nb * 32 + r32) * 128 + ks * 16 + hi * 8; const f32x4 w0 = *(const f32x4*)wp, w1 = *(const f32x4*)(wp + 4);
            const u32x4 w = pack8(w0, w1); bfr[nb] = __builtin_bit_cast(bf16x8, w); }
#pragma unroll
        for (int mb = 0; mb < 2; ++mb)
#pragma unroll
            for (int nb = 0; nb < 2; ++nb) acc[mb][nb] = __builtin_amdgcn_mfma_f32_32x32x16_bf16(af[mb], bfr[nb], acc[mb][nb], 0, 0, 0);
    }
#pragma unroll
    for (int nb = 0; nb < 2; ++nb) { const int i = ih * 64 + nb * 32 + r32; const float bias = bs[i]; const size_t row = (size_t)R0 + i;
#pragma unroll
        for (int mb = 0; mb < 2; ++mb)
#pragma unroll
            for (int jg = 0; jg < 4; ++jg) { const int d = mb * 32 + 8 * jg + 4 * hi;
                const u32x2 uw = *(const u32x2*)(UB + row * 256 + g * 64 + d);
                const float z0 = (acc[mb][nb][4 * jg] + bias) * bflo(uw[0]), z1 = (acc[mb][nb][4 * jg + 1] + bias) * bfhi(uw[0]), z2 = (acc[mb][nb][4 * jg + 2] + bias) * bflo(uw[1]), z3 = (acc[mb][nb][4 * jg + 3] + bias) * bfhi(uw[1]);
                *(u32x2*)(CAT + row * D + 512 + g * 64 + d) = (u32x2){pk2(z0, z1), pk2(z2, z3)}; } }
}

struct SchFG {
    pg8::Deal d; const char* W; const char* HBp;
    __device__ __forceinline__ bool next(int i, Unit& u) const { int tm, tn; if (!d.get(i, tm, tn)) return false; const int b = tn >> 6, jp = tn & 63;
        u.A = W + (size_t)tm * 256 * D * 2; u.B = HBp + ((size_t)b * SEQ + 2 * jp) * D * 2; u.nt = 16; u.pm = tm; u.pn = tn; u.aux = tn; return true; }
};
struct SchFGc {
    pg8::Deal d; const char* W; const char* HBp;
    __device__ __forceinline__ bool next(int i, Unit& u) const { int tm, tn; if (!d.get(i, tm, tn)) return false;
        u.A = W + (size_t)tm * 256 * D * 2; u.B = HBp + ((size_t)NLAT + tn * LCTX) * D * 2; u.nt = 16; u.pm = tm; u.pn = tn; u.aux = tn; return true; }
};
struct SchDftA {
    pg8::Deal d; const char* T; const char* G;
    __device__ __forceinline__ bool next(int i, Unit& u) const { int tm, tn; if (!d.get(i, tm, tn)) return false; const int b = tn >> 7, jp = tn & 127;
        u.A = T; u.B = G + ((size_t)b * 128 * 256 + 2 * jp) * 256 * 2; u.nt = 4; u.pm = 0; u.pn = tn; u.aux = tn; return true; }
};
struct SchDftC {
    pg8::Deal d; const char* T; const char* AP;
    __device__ __forceinline__ bool next(int i, Unit& u) const { int tm, tn; if (!d.get(i, tm, tn)) return false;
        u.A = T; u.B = AP + (size_t)tn * 256 * 256 * 2; u.nt = 4; u.pm = 0; u.pn = tn; u.aux = tn; return true; }
};
struct SchDftX {
    pg8::Deal d; const char* T; const char* Gc;
    __device__ __forceinline__ bool next(int i, Unit& u) const { int tm, tn; if (!d.get(i, tm, tn)) return false;
        u.A = T; u.B = Gc + (size_t)tn * 256 * 512 * 2; u.nt = 8; u.pm = 0; u.pn = tn; u.aux = tn; return true; }
};
struct SchMerge {
    pg8::Deal d; const char* CATp; const char* Wb;
    __device__ __forceinline__ bool next(int i, Unit& u) const { int tm, tn; if (!d.get(i / 3, tm, tn)) return false; const int br = i % 3; const int koff = br == 0 ? 0 : br == 1 ? 512 : 768;
        u.A = CATp + ((size_t)tm * 256 * D + koff) * 2; u.B = Wb + ((size_t)tn * 256 * D + koff) * 2; u.nt = br == 0 ? 8 : 4; u.pm = tm; u.pn = tn; u.aux = br; return true; }
};
struct SchMergeOne {
    int tm, tn; const char* CATp; const char* Wb;
    __device__ __forceinline__ bool next(int i, Unit& u) const { if (i >= 3) return false; const int br = i; const int koff = br == 0 ? 0 : br == 1 ? 512 : 768;
        u.A = CATp + ((size_t)tm * 256 * D + koff) * 2; u.B = Wb + ((size_t)tn * 256 * D + koff) * 2; u.nt = br == 0 ? 8 : 4; u.pm = tm; u.pn = tn; u.aux = br; return true; }
};
struct SchOne2D {
    int tm, tn; const char* A; const char* B; size_t sA, sB; int nt;
    __device__ __forceinline__ bool next(int i, Unit& u) const { if (i >= 1) return false; u.A = A + (size_t)tm * sA; u.B = B + (size_t)tn * sB; u.nt = nt; u.pm = tm; u.pn = tn; u.aux = 0; return true; }
};
struct SchFfn {
    pg8::Deal d; const char* Ap; const char* Bp; size_t sA, sBe, sBt; int nt, nte;
    __device__ __forceinline__ bool next(int i, Unit& u) const { int tm, tn; if (!d.get(i, tm, tn)) return false; const int e = tm / nte; tm = e * ETILES + (tm - e * nte);
        u.A = Ap + (size_t)tm * sA; u.B = Bp + (size_t)e * sBe + (size_t)tn * sBt; u.nt = nt; u.pm = tm; u.pn = tn; u.aux = e; return true; }
};

constexpr int XP_NTOT = NE * 96;
constexpr int XP_SPLIT = 1024;
constexpr int NST = 12;
constexpr int NPHASE = 1 + DEPTH * NST;
#define STAGE_FRAME(Fs) Frame Fs = F; { int t_ = F.wave * 64 + lane_id(); asm volatile("" : "+v"(t_)); Fs.tid = t_; Fs.lane = t_ & 63; }
__global__ void __launch_bounds__(NTHR, 2) mk_fwd(Args args) {
    extern __shared__ __attribute__((aligned(16))) unsigned char lds_raw[];
    Frame F;
    F.lds = (LAS unsigned char*)lds_raw;
    F.tid = threadIdx.x; F.lane = F.tid & 63; F.wave = __builtin_amdgcn_readfirstlane(F.tid >> 6); F.G = gridDim.x; F.blk = blockIdx.x; F.ws = args.ws;
    volatile LAS unsigned* MISC = (volatile LAS unsigned*)(F.lds + MISC_OFF);
    for (int u = F.tid; u < (LDS_BYTES - RING_BYTES) / 4; u += NTHR) ((LAS unsigned*)(F.lds + RING_BYTES))[u] = 0u;
    __syncthreads();
    unsigned* ctl = (unsigned*)(F.ws + O_CTL);
    const int lo = args.ph_lo, hi = args.ph_hi;
    XcdBarrier bar; bar.bar = ctl + CW_BAR; bar.x = 0; bar.st = nullptr;
    if (hi - lo > 1) bar = xcd_barrier_post(ctl + CW_BAR, MISC + 8);
#ifndef STAGE_MASK
#define STAGE_MASK 0x1fff
#endif
#define SON(s) (((STAGE_MASK) >> (s)) & 1)
#ifndef SITE_MASK
#define SITE_MASK 0xffff
#endif
#define SITE_ON(s) (((SITE_MASK) >> (s)) & 1)
#ifndef DUP_STAGE
#define DUP_STAGE -1
#endif
#define REPS(s) ((DUP_STAGE) == (s) ? 2 : 1)
#define IN(k) (lo <= (k) && (k) < hi)
    volatile LAS unsigned* fw = MISC + 16;
#define SEAM_MAXL(k) ((k) == 0 ? 1 : ((((k) - 1) % NST) >= 11 ? ((k) - 1) / NST + 2 : ((k) - 1) / NST + 1))
#define SEAM(k) do { if (IN(k) && IN((k) + 1)) { STAGE_FRAME(Fb); const int ml_ = SEAM_MAXL(k); xcd_barrier_fill(bar, Fb, ctl, fw, ml_ < DEPTH - 1 ? ml_ : DEPTH - 1); } } while (0)
    const int gw = F.blk * NWAVES + F.wave, NGW = F.G * NWAVES;

    if (SON(12) && IN(0)) for (int rep = 0; rep < REPS(12); ++rep) {
        STAGE_FRAME(Fs);
        modvec_units(Fs, args);
    }
    SEAM(0);

#pragma unroll 1
    for (int l = 0; l < DEPTH; ++l) {
        const int pb = 1 + l * NST;

        if (SON(0) && IN(pb + 0) && l == 0) { STAGE_FRAME(Fs); phase_norm1_in(Fs, args); __syncthreads();
            tables(Fs); convert_nonexpert(Fs, args, 0, gw, NGW); for (int u = F.blk; u < 256; u += F.G) fold_unit(Fs, args, 0, u); }
        if (l == 0) SEAM(pb + 0);

        if (SON(1) && IN(pb + 1)) for (int rep = 0; rep < REPS(1); ++rep) {
            unsigned char* ws = opq(F.ws);
            const char* btin = (const char*)(ws + O_BTIN + (size_t)(l & 1) * SZ_BTIN); const char* HBc = (const char*)(ws + O_HB);
            const pg8::Geom gN{D, D, 128u * D * 2u, 128u * D * 2u};
            int off = 0; const int nMr = (l == DEPTH - 1) ? 128 : 130;
            if (SITE_ON(1)) { pg8::Sch2D S; S.d.init(130, 4, F.G, F.blk, off); S.A = HBc; S.B = btin; S.sA = (size_t)256 * D * 2; S.sB = (size_t)256 * D * 2; S.nt = 16;
              EpiQKVU E{(bf16_t*)(ws + O_QB), (bf16_t*)(ws + O_KVB), (bf16_t*)(ws + O_UB), (const float*)(ws + O_ROPEC), (const float*)(ws + O_ROPES), 0.125f * LOG2E}; pg8::gemm_phase(F.lds, F.wave, gN, S, E); off += 520; }
            if (SITE_ON(4)) { pg8::Sch2D S; S.d.init(1, nMr, F.G, F.blk, off); S.A = btin + (size_t)1024 * D * 2; S.B = HBc; S.sA = 0; S.sB = (size_t)256 * D * 2; S.nt = 16;
              EpiVsT E{(bf16_t*)(ws + O_VST)}; pg8::gemm_phase(F.lds, F.wave, gN, S, E); off += nMr; }
            if (SITE_ON(5)) { SchFG S; S.d.init(2, 128, F.G, F.blk, off); S.W = btin + (size_t)1280 * D * 2; S.HBp = HBc;
              const pg8::Geom gF{D, 128 * D, 128u * D * 2u, (unsigned)(D * 2)};
              EpiFG E{(bf16_t*)(ws + O_GB)}; pg8::gemm_phase(F.lds, F.wave, gF, S, E); off += 256; }
            if (SITE_ON(6) && l != DEPTH - 1) { SchFGc S; S.d.init(2, 2, F.G, F.blk, off); S.W = btin + (size_t)1280 * D * 2; S.HBp = HBc;
              EpiFGc E{(bf16_t*)(ws + O_GC)}; pg8::gemm_phase(F.lds, F.wave, gN, S, E); off += 4; }
            if (SITE_ON(0)) { pg8::Sch2D S; S.d.init(nMr, 12, F.G, F.blk, off); S.A = (const char*)(ws + O_HB8); S.B = (const char*)(ws + O_BTG8 + (size_t)(l & 1) * 3072 * D); S.sA = (size_t)256 * D; S.sB = (size_t)256 * D; S.nt = 8;
              const pg8::Geom g8{D / 2, D / 2, 128u * D, 128u * D};
              EpiAct<4> E{(bf16_t*)(ws + O_GATES), 3072, 1.0f / 32.0f}; pg8::gemm_phase<EpiAct<4>, pg8::Sch2D, true>(F.lds, F.wave, g8, S, E); }
        }
        SEAM(pb + 1);

        if (SON(2) && IN(pb + 2)) for (int rep = 0; rep < REPS(2); ++rep) {
            unsigned char* ws = opq(F.ws);
            const bool hv = (l != DEPTH - 1); const bool heavy = hv && F.blk >= 8 && F.blk < 16; const int Gl = hv ? F.G - 8 : F.G, bl = (hv && F.blk >= 16) ? F.blk - 8 : F.blk;
            if (SITE_ON(8) && !heavy) { SchDftA S; S.d.init(1, 256, Gl, bl, 0); S.T = (const char*)(ws + O_TA); S.G = (const char*)(ws + O_GB);
              const pg8::Geom gA{256, 65536, 128u * 256u * 2u, 256u * 2u};
              EpiDftA E{(bf16_t*)(ws + O_AP), (const float*)(ws + O_TWC), (const float*)(ws + O_TWS)}; pg8::gemm_phase(F.lds, F.wave, gA, S, E); }
            if (SITE_ON(9) && l != DEPTH - 1 && !heavy) { SchDftX S; S.d.init(1, 2, Gl, bl, 32); S.T = (const char*)(ws + O_TX); S.Gc = (const char*)(ws + O_GC);
              const pg8::Geom gX{512, 512, 128u * 512u * 2u, 128u * 512u * 2u};
              EpiDftX E{(bf16_t*)(ws + O_CAT)}; pg8::gemm_phase(F.lds, F.wave, gX, S, E); }
            __syncthreads();
            const float* sinkv = ldin(9) + (size_t)l * 8;
            { STAGE_FRAME(Fs); if (SITE_ON(10)) for (int u = (F.blk + F.G - 8) % F.G; u < (l == DEPTH - 1 ? 512 : 520); u += F.G) attn_unit(Fs, u, sinkv); }
            { STAGE_FRAME(Fs); if (SITE_ON(11) && !heavy) for (int c = (bl + Gl - 16) % Gl; c < (l == DEPTH - 1 ? 256 : 260); c += Gl) sgu_unit(Fs, args, l, c); }
        }
        SEAM(pb + 2);

        if (SON(3) && IN(pb + 3)) for (int rep = 0; rep < REPS(3); ++rep) {
            unsigned char* ws = opq(F.ws);
            SchDftC S; S.d.init(1, 256, F.G, F.blk, 0); S.T = (const char*)(ws + O_TC); S.AP = (const char*)(ws + O_AP);
            const pg8::Geom gC{256, 256, 128u * 256u * 2u, 128u * 256u * 2u};
            EpiDftC E{(bf16_t*)(ws + O_CAT)}; pg8::gemm_phase(F.lds, F.wave, gC, S, E);
        }
        SEAM(pb + 3);

        if (SON(4) && IN(pb + 4)) for (int rep = 0; rep < REPS(4); ++rep) {
            unsigned char* ws = opq(F.ws); const char* btbr = (const char*)(ws + O_BTBR + (size_t)(l & 1) * SZ_SQ);
            SchMerge S; S.d.init(128, 4, F.G, F.blk, 0);   S.CATp = (const char*)(ws + O_CAT); S.Wb = btbr;
            const pg8::Geom gN{D, D, 128u * D * 2u, 128u * D * 2u};
            EpiMerge E{(const unsigned char*)(ws + O_GATES), (bf16_t*)(ws + O_MB)}; pg8::gemm_phase(F.lds, F.wave, gN, S, E);
        }
        SEAM(pb + 4);

        if (SON(5) && IN(pb + 5)) for (int rep = 0; rep < ((DUP_STAGE) == 5 && l == 0 ? 2 : 1); ++rep) {
            unsigned char* ws = opq(F.ws); const char* bto = (const char*)(ws + O_BTO + (size_t)(l & 1) * SZ_SQ);
            const float* modv = (const float*)(ws + O_MODV) + (size_t)l * 3 * NMOD;
            pg8::Sch2D S; S.d.init(128, 4, F.G, F.blk, 0); S.A = (const char*)(ws + O_MB); S.B = bto; S.sA = (size_t)256 * D * 2; S.sB = (size_t)256 * D * 2; S.nt = 16;
            const pg8::Geom gN{D, D, 128u * D * 2u, 128u * D * 2u};
            EpiOut E{ldin(0), (bf16_t*)(ws + O_XW), modv, l == 0 ? 1 : 0}; pg8::gemm_phase(F.lds, F.wave, gN, S, E);
        }
        SEAM(pb + 5);

        if (SON(6) && IN(pb + 6)) for (int rep = 0; rep < REPS(6); ++rep) {
            const bool cx = (l != DEPTH - 1);
            if (cx && F.blk < 8) {
                unsigned char* ws = opq(F.ws);
                SchMergeOne S; S.tm = 128 + (F.blk >> 2); S.tn = F.blk & 3; S.CATp = (const char*)(ws + O_CAT); S.Wb = (const char*)(ws + O_BTBR + (size_t)(l & 1) * SZ_SQ);
                const pg8::Geom gN{D, D, 128u * D * 2u, 128u * D * 2u};
                EpiMerge E{(const unsigned char*)(ws + O_GATES), (bf16_t*)(ws + O_MB)}; pg8::gemm_phase(F.lds, F.wave, gN, S, E);
            } else { STAGE_FRAME(Fs); const int w0 = cx ? 8 : 0; phase_norm2(Fs, args, l, 0, NLAT, (F.blk - w0) * NWAVES + F.wave, (F.G - w0) * NWAVES); }
        }
        SEAM(pb + 6);

        if (SON(7) && IN(pb + 7)) for (int rep = 0; rep < REPS(7); ++rep) {
            { STAGE_FRAME(Fs); for (int u = F.blk; u < 32; u += F.G) select_unit(Fs, u); }
            if (F.blk < 32) wg_signal(ctl + CW_CNT + 64 * l + 16, F.wave); else __syncthreads();
            const bool cx = (l != DEPTH - 1); const int nconv = cx ? F.G - 8 : F.G;
            if (cx && F.blk >= nconv) {
                unsigned char* ws = opq(F.ws); const int j = F.blk - nconv;
                SchOne2D S; S.tm = 128 + (j >> 2); S.tn = j & 3; S.A = (const char*)(ws + O_MB); S.B = (const char*)(ws + O_BTO + (size_t)(l & 1) * SZ_SQ); S.sA = (size_t)256 * D * 2; S.sB = (size_t)256 * D * 2; S.nt = 16;
                const pg8::Geom gN{D, D, 128u * D * 2u, 128u * D * 2u};
                const float* modv = (const float*)(ws + O_MODV) + (size_t)l * 3 * NMOD;
                EpiOut E{ldin(2) - (size_t)NLAT * D, (bf16_t*)(ws + O_XW), modv, l == 0 ? 1 : 0}; pg8::gemm_phase(F.lds, F.wave, gN, S, E);
                wg_signal(ctl + CW_CNT + 64 * l + 32, F.wave);
            }
            __syncthreads();
            { STAGE_FRAME(Fs); while (fill_one(Fs, ctl, fw, l)) {} }
            __syncthreads();
            if (l + 1 < DEPTH && F.blk >= 32 && F.blk < nconv) { STAGE_FRAME(Fs); convert_nonexpert(Fs, args, l + 1, (F.blk - 32) * NWAVES + F.wave, (nconv - 32) * NWAVES); for (int u = F.blk - 32; u < 256; u += nconv - 32) fold_unit(Fs, args, l + 1, u); }
        }

        if (SON(8) && IN(pb + 8)) for (int rep = 0; rep < REPS(8); ++rep) {
            const bool cx = (l != DEPTH - 1); unsigned* cnt = ctl + CW_CNT + 64 * l;
            if (cx && F.blk < 32) { wg_wait(cnt + 32, 8u, F.wave); STAGE_FRAME(Fs); phase_norm2(Fs, args, l, NLAT, NR, F.blk * NWAVES + F.wave, 32 * NWAVES); wg_signal(cnt, F.wave); }
            wg_wait(cnt + 16, 32u, F.wave);
            { STAGE_FRAME(Fs); phase_gather(Fs, true); }
            if (cx && F.blk >= 32 && F.blk < 64) { wg_wait(cnt, 32u, F.wave); STAGE_FRAME(Fs); select_unit(Fs, 32 + F.blk - 32); }
        }
        SEAM(pb + 8);

        if (SON(9) && IN(pb + 9)) for (int rep = 0; rep < REPS(9); ++rep) {
            unsigned char* ws = opq(F.ws);
            SchFfn S; S.nte = (l == DEPTH - 1) ? 16 : ETILES; S.d.init(NE * S.nte, 16, F.G, F.blk, 0); S.Ap = (const char*)(ws + O_XE); S.Bp = (const char*)(ws + O_BTGU) + (size_t)(l & 1) * SZ_GU8; S.sA = (size_t)256 * D; S.sBe = (size_t)4096 * D; S.sBt = (size_t)256 * D; S.nt = 8;
            const pg8::Geom g8{D / 2, D / 2, 128u * D, 128u * D};
            EpiFfn1 E{(bf16_t*)(ws + O_ACT)}; pg8::gemm_phase<EpiFfn1, SchFfn, true>(F.lds, F.wave, g8, S, E);
        }
        SEAM(pb + 9);

        if (SON(10) && IN(pb + 10)) for (int rep = 0; rep < REPS(10); ++rep) {
            unsigned char* ws = opq(F.ws);
            SchFfn S; S.nte = (l == DEPTH - 1) ? 16 : ETILES; S.d.init(NE * S.nte, 4, F.G, F.blk, 0); S.Ap = (const char*)(ws + O_ACT); S.Bp = (const char*)(ws + O_BTD) + (size_t)(l & 1) * SZ_D8; S.sA = (size_t)256 * FF; S.sBe = (size_t)D * FF; S.sBt = (size_t)256 * FF; S.nt = 16;
            const pg8::Geom gD{FF / 2, FF / 2, 128u * FF, 128u * FF};
            EpiStoreScaled E{(bf16_t*)(ws + O_YB), D, 1.0f / 32.0f};       pg8::gemm_phase<EpiStoreScaled, SchFfn, true>(F.lds, F.wave, gD, S, E);
        }
        SEAM(pb + 10);

        if (SON(11) && IN(pb + 11)) { STAGE_FRAME(Fs); phase_combine(Fs, args, l); }
        if (l + 1 < DEPTH) SEAM(pb + 11);
    }
#undef IN
#undef SEAM
}

extern "C" void kernel_launch(void* const* d_in, const int* in_sizes, int n_in, void* d_out, int out_size, void* d_ws, size_t ws_size, hipStream_t stream) {
    static int grid = 0;
    if (grid == 0) {
        if (n_in != 21 || out_size != NLAT * D || ws_size < O_END) { fprintf(stderr, "kernel_launch: unexpected shapes (n_in %d out %d ws %zu need %zu)\n", n_in, out_size, ws_size, (size_t)O_END); grid = -1; return; }
        int dev = 0, cus = 0;
        if (hipGetDevice(&dev) != hipSuccess || hipDeviceGetAttribute(&cus, hipDeviceAttributeMultiprocessorCount, dev) != hipSuccess) { grid = -1; return; }
        if (hipFuncSetAttribute((const void*)mk_fwd, hipFuncAttributeMaxDynamicSharedMemorySize, LDS_BYTES) != hipSuccess) { fprintf(stderr, "kernel_launch: hipFuncSetAttribute failed\n"); grid = -1; return; }
        int per_cu = 0;
        if (hipOccupancyMaxActiveBlocksPerMultiprocessor(&per_cu, (const void*)mk_fwd, NTHR, LDS_BYTES) != hipSuccess || per_cu < 1) fprintf(stderr, "kernel_launch: occupancy query reports %d\n", per_cu);
        (void)hipGetLastError();
        grid = cus;
    }
    if (grid < 0) return;
    (void)hipMemsetAsync((char*)d_ws + O_CTL, 0, CTL_BYTES, stream);
    Args a{};
    for (int i = 0; i < 21; ++i) a.in[i] = (const float*)d_in[i];
    a.out = (float*)d_out; a.ws = (unsigned char*)d_ws;
#if MK_MULTI
    for (int p = 0; p < NPHASE; ++p) {
        if (p > 0) { const int l = (p - 1) / NST, s = (p - 1) % NST; if (s == 0 && l > 0) continue; }
        a.ph_lo = p; a.ph_hi = p + 1;
        hipLaunchKernelGGL(mk_fwd, dim3(grid), dim3(NTHR), LDS_BYTES, stream, a);
    }
#else
    a.ph_lo = 0; a.ph_hi = NPHASE;
    hipLaunchKernelGGL(mk_fwd, dim3(grid), dim3(NTHR), LDS_BYTES, stream, a);
#endif
}
```
